# Optimizing an MI355X kernel written in HIP

```python
import math
import jax
import jax.numpy as jnp
from jax import lax
import numpy as np

D_MODEL = 1024
BATCH = 4
SEQ = 4096
DEPTH = 2

GRID_W = 64
RET_HEADS = 4
RET_DK = 64
RET_DV = 64
NAT_HEADS = 4
NAT_DIM = 64
NAT_KH = 8
NAT_KW = 16
HGRN_HEADS = 4
HGRN_DK = 64
HGRN_DV = 64
DIFF_HEADS = 4
DIFF_DQK = 64
DIFF_DV = 128
N_BRANCH = 4
CHUNK = 64
Q_BLOCK = 128
N_EXPERTS = 64
TOP_K = 8
N_GROUPS = 8
TOPK_GROUPS = 4
EXPERT_HIDDEN = 256
SHARED_HIDDEN = 256
ROUTED_SCALE = 2.5
MOE_BLOCK = 128
EPS = 1e-5
MASK_VALUE = -1e30
ALPHA = (2.0 * DEPTH) ** 0.25
BETA = (8.0 * DEPTH) ** -0.25

RET_QK = RET_HEADS * RET_DK
RET_V = RET_HEADS * RET_DV
NAT_W = NAT_HEADS * NAT_DIM
HGRN_K = HGRN_HEADS * HGRN_DK
HGRN_V = HGRN_HEADS * HGRN_DV
DIFF_QK = DIFF_HEADS * 2 * DIFF_DQK
DIFF_V = DIFF_HEADS * DIFF_DV
SPLITS = (RET_QK, RET_QK, RET_V, RET_V,
          NAT_W, NAT_W, NAT_W,
          HGRN_K, HGRN_K, HGRN_K, HGRN_V, HGRN_V,
          DIFF_QK, DIFF_QK, DIFF_V)
IN_WIDTH = sum(SPLITS)

kernel_name = 'hybrid_gated_encoder_block'


def layer_norm(x, g, b):
    xf = x.astype(jnp.float32)
    mu = jnp.mean(xf, axis=-1, keepdims=True)
    var = jnp.mean(jnp.square(xf - mu), axis=-1, keepdims=True)
    return ((xf - mu) * lax.rsqrt(var + EPS) * g + b).astype(x.dtype)


def rms_norm(x, g):
    xf = x.astype(jnp.float32)
    return (xf * lax.rsqrt(jnp.mean(jnp.square(xf), axis=-1, keepdims=True) + EPS) * g).astype(x.dtype)


def split_heads(a, n_heads):
    b, t, _ = a.shape
    return a.reshape(b, t, n_heads, -1).transpose(0, 2, 1, 3)


def merge_heads(a):
    b, h, t, d = a.shape
    return a.transpose(0, 2, 1, 3).reshape(b, t, h * d)


def split_columns(p):
    offsets = np.cumsum(SPLITS)[:-1].tolist()
    return jnp.split(p, offsets, axis=-1)


def chunk_recurrence(q, k, v, log_f):
    b, h, t, dk = q.shape
    dv = v.shape[-1]
    n = t // CHUNK

    def to_chunks(a):
        return a.reshape(b, h, n, CHUNK, a.shape[-1]).transpose(2, 0, 1, 3, 4)

    lower_tri = jnp.tril(jnp.ones((CHUNK, CHUNK), dtype=bool))[:, :, None]

    def step(state, inp):
        qc, kc, vc, fc = inp
        g = jnp.cumsum(fc.astype(jnp.float32), axis=-2)
        diff = g[..., :, None, :] - g[..., None, :, :]
        decay = jnp.where(lower_tri, jnp.exp(jnp.where(lower_tri, diff, 0.0)), 0.0)
        scores = jnp.einsum('bhik,bhjk,bhijk->bhij', qc, kc, decay)
        intra = jnp.einsum('bhij,bhjv->bhiv', scores, vc)
        inter = jnp.einsum('bhik,bhkv->bhiv', qc * jnp.exp(g), state)
        g_last = g[..., -1, :]
        new_state = (jnp.exp(g_last)[..., None] * state
                     + jnp.einsum('bhjk,bhjv->bhkv', kc * jnp.exp(g_last[..., None, :] - g), vc))
        return new_state, intra + inter

    s0 = jnp.zeros((b, h, dk, dv), jnp.float32)
    _, out = lax.scan(step, s0, (to_chunks(q), to_chunks(k), to_chunks(v), to_chunks(log_f)))
    return out.transpose(1, 2, 0, 3, 4).reshape(b, h, t, dv).astype(v.dtype)


def bidirectional_recurrence(q, k_fwd, k_bwd, v, log_f_fwd, log_f_bwd):
    rev = lambda a: jnp.flip(a, axis=2)
    fwd = chunk_recurrence(q, k_fwd, v, log_f_fwd)
    bwd = rev(chunk_recurrence(rev(q), rev(k_bwd), rev(v), rev(log_f_bwd)))
    return fwd + bwd


def retention(q, k, v, g, gn):
    b, t, _ = q.shape
    qh = split_heads(q, RET_HEADS)
    kh = split_heads(k, RET_HEADS) * (RET_DK ** -0.5)
    vh = split_heads(v, RET_HEADS)
    idx = jnp.arange(RET_HEADS, dtype=jnp.float32)
    shape = (b, RET_HEADS, t, RET_DK)
    log_fwd = jnp.broadcast_to(jnp.log1p(-jnp.exp2(-5.0 - 2.0 * idx))[None, :, None, None], shape)
    log_bwd = jnp.broadcast_to(jnp.log1p(-jnp.exp2(-6.0 - 2.0 * idx))[None, :, None, None], shape)
    o = bidirectional_recurrence(qh, kh, kh, vh, log_fwd, log_bwd)
    return merge_heads(rms_norm(o, gn[:, None, :])) * jax.nn.silu(g)


def neighbourhood_attention(q, k, v, rpb):
    b, t, _ = q.shape
    rows = t // GRID_W
    kh = min(NAT_KH, rows)
    qg = split_heads(q, NAT_HEADS).reshape(b, NAT_HEADS, rows, GRID_W, NAT_DIM)
    kg = split_heads(k, NAT_HEADS).reshape(b, NAT_HEADS, rows, GRID_W, NAT_DIM)
    vg = split_heads(v, NAT_HEADS).reshape(b, NAT_HEADS, rows, GRID_W, NAT_DIM)
    r = jnp.arange(rows)
    row_start = jnp.clip(r - kh // 2, 0, rows - kh)
    row_idx = row_start[:, None] + jnp.arange(kh)[None, :]
    k_blk = kg[:, :, row_idx]
    v_blk = vg[:, :, row_idx]
    c = jnp.arange(GRID_W)
    col_start = jnp.clip(c - NAT_KW // 2, 0, GRID_W - NAT_KW)
    col_mask = (c[None, :] >= col_start[:, None]) & (c[None, :] < col_start[:, None] + NAT_KW)
    dr = row_idx - r[:, None] + (NAT_KH - 1)
    dc = jnp.clip(c[None, :] - c[:, None], -(NAT_KW - 1), NAT_KW - 1) + (NAT_KW - 1)
    bias = rpb[:, dr[:, None, :, None], dc[None, :, None, :]]
    s = jnp.einsum('bhrqd,bhrkcd->bhrqkc', qg, k_blk).astype(jnp.float32) * (NAT_DIM ** -0.5) + bias
    s = jnp.where(col_mask[:, None, :], s, MASK_VALUE)
    p = jax.nn.softmax(s.reshape(b, NAT_HEADS, rows, GRID_W, kh * GRID_W), axis=-1)
    p = p.reshape(b, NAT_HEADS, rows, GRID_W, kh, GRID_W)
    p = jnp.where(col_mask[:, None, :], p, 0.0).astype(v.dtype)
    o = jnp.einsum('bhrqkc,bhrkcd->bhrqd', p, v_blk)
    return merge_heads(o.reshape(b, NAT_HEADS, t, NAT_DIM))


def hgrn2(q, f_fwd, f_bwd, i, g, lower, gn):
    def gate(f_pre, lb):
        f_pre = f_pre.astype(jnp.float32)
        f = lb + (1.0 - lb) * jax.nn.sigmoid(f_pre)
        log_f = jnp.log(f)
        k = (1.0 - lb) * jax.nn.sigmoid(-f_pre)
        return split_heads(k, HGRN_HEADS), split_heads(log_f, HGRN_HEADS)

    k_f, lf_f = gate(f_fwd, lower[0])
    k_b, lf_b = gate(f_bwd, lower[1])
    qh = split_heads(jax.nn.silu(q), HGRN_HEADS)
    vh = split_heads(i, HGRN_HEADS)
    o = bidirectional_recurrence(qh, k_f, k_b, vh, lf_f, lf_b)
    return merge_heads(rms_norm(o, gn[:, None, :])) * jax.nn.silu(g)


def diff_attention(q, k, v, lam_params, subln, layer):
    b, t, _ = q.shape
    lam_init = 0.8 - 0.6 * math.exp(-0.3 * layer)
    qh = split_heads(q, DIFF_HEADS)
    kh = split_heads(k, DIFF_HEADS)
    vh = split_heads(v, DIFF_HEADS)
    q1, q2 = qh[..., :DIFF_DQK], qh[..., DIFF_DQK:]
    k1, k2 = kh[..., :DIFF_DQK], kh[..., DIFF_DQK:]
    lam = (jnp.exp(jnp.sum(lam_params[0] * lam_params[1]))
           - jnp.exp(jnp.sum(lam_params[2] * lam_params[3])) + lam_init)
    slopes = jnp.exp2(-8.0 * (jnp.arange(DIFF_HEADS, dtype=jnp.float32) + 1.0) / DIFF_HEADS)
    scale = DIFF_DQK ** -0.5
    kpos = jnp.arange(t)
    nb = t // Q_BLOCK

    def to_blocks(a):
        return a.reshape(b, DIFF_HEADS, nb, Q_BLOCK, DIFF_DQK).transpose(2, 0, 1, 3, 4)

    def block(inp):
        q1c, q2c, qpos = inp
        bias = -slopes[:, None, None] * jnp.abs(qpos[:, None] - kpos[None, :]).astype(jnp.float32)
        s1 = jnp.einsum('bhqd,bhkd->bhqk', q1c, k1).astype(jnp.float32) * scale + bias
        s2 = jnp.einsum('bhqd,bhkd->bhqk', q2c, k2).astype(jnp.float32) * scale + bias
        a = jax.nn.softmax(s1, axis=-1) - lam * jax.nn.softmax(s2, axis=-1)
        return jnp.einsum('bhqk,bhkd->bhqd', a.astype(vh.dtype), vh)

    o = lax.map(block, (to_blocks(q1), to_blocks(q2), kpos.reshape(nb, Q_BLOCK)))
    o = o.transpose(1, 2, 0, 3, 4).reshape(b, DIFF_HEADS, t, DIFF_DV)
    return merge_heads(rms_norm(o, subln[:, None, :]) * (1.0 - lam_init))


def mixer(h, w_in, w_gate, b_gate, w_br_ret, w_br_nat, w_br_hgrn, w_br_diff, w_out,
          ret_gn, nat_rpb, hgrn_lower, hgrn_gn, diff_lambda, diff_subln, layer):
    (rq, rk, rv, rg, nq, nk, nv, hq, hff, hfb, hi, hg, dq, dk, dv) = split_columns(h @ w_in)
    y_ret = retention(rq, rk, rv, rg, ret_gn)
    y_nat = neighbourhood_attention(nq, nk, nv, nat_rpb)
    y_hgrn = hgrn2(hq, hff, hfb, hi, hg, hgrn_lower, hgrn_gn)
    y_diff = diff_attention(dq, dk, dv, diff_lambda, diff_subln, layer)
    gates = jax.nn.sigmoid(h @ w_gate + b_gate).reshape(h.shape[0], h.shape[1], N_BRANCH, D_MODEL)
    merged = (gates[:, :, 0] * (y_ret @ w_br_ret) + gates[:, :, 1] * (y_nat @ w_br_nat)
              + gates[:, :, 2] * (y_hgrn @ w_br_hgrn) + gates[:, :, 3] * (y_diff @ w_br_diff))
    return merged @ w_out


def moe(h, w_router, router_bias, w_e_gate, w_e_up, w_e_down, w_s_gate, w_s_up, w_s_down):
    b, t, d = h.shape
    xt = h.reshape(b * t, d)
    n = xt.shape[0]
    scores = jax.nn.sigmoid((xt @ w_router).astype(jnp.float32))
    biased = scores + router_bias.astype(jnp.float32)
    grp = biased.reshape(n, N_GROUPS, N_EXPERTS // N_GROUPS)
    grp_score = jnp.sum(lax.top_k(grp, 2)[0], axis=-1)
    _, top_grp = lax.top_k(grp_score, TOPK_GROUPS)
    grp_mask = jnp.any(jax.nn.one_hot(top_grp, N_GROUPS, dtype=jnp.bool_), axis=-2)
    expert_mask = jnp.repeat(grp_mask, N_EXPERTS // N_GROUPS, axis=-1)
    _, top_idx = lax.top_k(jnp.where(expert_mask, biased, MASK_VALUE), TOP_K)
    top_w = jnp.take_along_axis(scores, top_idx, axis=-1)
    top_w = top_w / (jnp.sum(top_w, axis=-1, keepdims=True) + 1e-20) * ROUTED_SCALE
    combine = jnp.einsum('nk,nke->ne', top_w, jax.nn.one_hot(top_idx, N_EXPERTS, dtype=top_w.dtype))
    nblk = n // MOE_BLOCK

    def block(inp):
        xb, cb = inp
        hid = jax.nn.silu(jnp.einsum('nd,edh->neh', xb, w_e_gate)) * jnp.einsum('nd,edh->neh', xb, w_e_up)
        hid = hid * cb[..., None].astype(hid.dtype)
        return jnp.einsum('neh,ehd->nd', hid, w_e_down)

    routed = lax.map(block, (xt.reshape(nblk, MOE_BLOCK, d), combine.reshape(nblk, MOE_BLOCK, N_EXPERTS)))
    shared = (jax.nn.silu(xt @ w_s_gate) * (xt @ w_s_up)) @ w_s_down
    return (routed.reshape(n, d) + shared).reshape(b, t, d)


def setup_inputs(seed: int = 0) -> dict:
    key = jax.random.key(seed)
    ks = iter(jax.random.split(key, 32))
    nrm = lambda shape, scale: scale * jax.random.normal(next(ks), shape, jnp.float32)
    L, D = DEPTH, D_MODEL
    return {
        'x': nrm((BATCH, SEQ, D), 1.0),
        'ln_in_g': 1.0 + nrm((D,), 0.02),
        'ln_in_b': nrm((D,), 0.02),
        'w_in': nrm((L, D, IN_WIDTH), D ** -0.5),
        'w_gate': nrm((L, D, N_BRANCH * D), D ** -0.5),
        'b_gate': nrm((L, N_BRANCH * D), 0.1),
        'w_br_ret': nrm((L, RET_V, D), RET_V ** -0.5),
        'w_br_nat': nrm((L, NAT_W, D), NAT_W ** -0.5),
        'w_br_hgrn': nrm((L, HGRN_V, D), HGRN_V ** -0.5),
        'w_br_diff': nrm((L, DIFF_V, D), DIFF_V ** -0.5),
        'w_out': nrm((L, D, D), BETA * D ** -0.5),
        'ret_gn': 1.0 + nrm((L, RET_HEADS, RET_DV), 0.02),
        'nat_rpb': nrm((L, NAT_HEADS, 2 * NAT_KH - 1, 2 * NAT_KW - 1), 0.1),
        'hgrn_lb': nrm((L, 2, HGRN_K), 1.0),
        'hgrn_gn': 1.0 + nrm((L, HGRN_HEADS, HGRN_DV), 0.02),
        'diff_lambda': nrm((L, 4, DIFF_DQK), 0.1),
        'diff_subln': 1.0 + nrm((L, DIFF_HEADS, DIFF_DV), 0.02),
        'ln1_g': 1.0 + nrm((L, D), 0.02),
        'ln1_b': nrm((L, D), 0.02),
        'w_router': nrm((L, D, N_EXPERTS), D ** -0.5),
        'router_bias': nrm((L, N_EXPERTS), 0.01),
        'w_e_gate': nrm((L, N_EXPERTS, D, EXPERT_HIDDEN), D ** -0.5),
        'w_e_up': nrm((L, N_EXPERTS, D, EXPERT_HIDDEN), D ** -0.5),
        'w_e_down': nrm((L, N_EXPERTS, EXPERT_HIDDEN, D), BETA * EXPERT_HIDDEN ** -0.5),
        'w_s_gate': nrm((L, D, SHARED_HIDDEN), D ** -0.5),
        'w_s_up': nrm((L, D, SHARED_HIDDEN), D ** -0.5),
        'w_s_down': nrm((L, SHARED_HIDDEN, D), BETA * SHARED_HIDDEN ** -0.5),
        'ln2_g': 1.0 + nrm((L, D), 0.02),
        'ln2_b': nrm((L, D), 0.02),
    }


def reference(x, ln_in_g, ln_in_b, w_in, w_gate, b_gate, w_br_ret, w_br_nat, w_br_hgrn,
              w_br_diff, w_out, ret_gn, nat_rpb, hgrn_lb, hgrn_gn, diff_lambda, diff_subln,
              ln1_g, ln1_b, w_router, router_bias, w_e_gate, w_e_up, w_e_down,
              w_s_gate, w_s_up, w_s_down, ln2_g, ln2_b):
    p = jax.nn.softmax(hgrn_lb.astype(jnp.float32), axis=0)
    hgrn_lower = jnp.cumsum(p, axis=0) - p[0]
    h = layer_norm(x, ln_in_g, ln_in_b)
    for l in range(DEPTH):
        m = mixer(h, w_in[l], w_gate[l], b_gate[l], w_br_ret[l], w_br_nat[l], w_br_hgrn[l],
                  w_br_diff[l], w_out[l], ret_gn[l], nat_rpb[l], hgrn_lower[l], hgrn_gn[l],
                  diff_lambda[l], diff_subln[l], l)
        h = layer_norm(ALPHA * h + m, ln1_g[l], ln1_b[l])
        f = moe(h, w_router[l], router_bias[l], w_e_gate[l], w_e_up[l], w_e_down[l],
                w_s_gate[l], w_s_up[l], w_s_down[l])
        h = layer_norm(ALPHA * h + f, ln2_g[l], ln2_b[l])
    return h
```

```cpp
#include <hip/hip_runtime.h>
#include <stdint.h>
#include <stdio.h>

typedef unsigned short bf16_t;
typedef unsigned int u32;

#define NTOK 16384
#define SEQ 4096
#define DM 1024
#define INW 4608
#define NLAYER 2
#define NEXP 64
#define EH 256
#define ALPHA_F 1.41421356237309515f
#define LN_EPS 1e-5f
#define NTHREADS 512

#define MIB ((size_t)1 << 20)
#define OFF_BAR   ((size_t)0)
#define OFF_CNT   ((size_t)16384)
#define CTL_ZERO_BYTES ((size_t)32768)
#define OFF_WTIG  (1 * MIB)
#define OFF_WTBR  (18 * MIB)
#define OFF_WTOUT (OFF_WTBR + 2560 * 1024)
#define OFF_HB    (23 * MIB)
#define OFF_X     (55 * MIB)
#define OFF_EXPW  (87 * MIB)
#define OFF_EXPGU OFF_EXPW
#define OFF_EXPDN (OFF_EXPW + 65 * MIB)
#define OFF_OTMP  OFF_EXPW
#define OFF_ROUTE (185 * MIB)
#define OFF_TOPE  OFF_ROUTE
#define OFF_TOPW  (OFF_ROUTE + 512 * 1024)
#define OFF_TOPP  (OFF_ROUTE + 1024 * 1024)
#define OFF_R     (191 * MIB)
#define OFF_PROJ  OFF_R
#define OFF_GATES (OFF_R + 144 * MIB)
#define OFF_Y     (OFF_R + 272 * MIB)
#define OFF_MERGED OFF_R
#define OFF_HID   OFF_R
#define OFF_OUTS  (OFF_R + 72 * MIB)
#define OFF_DTMP  OFF_X
#define WS_END    (OFF_R + 328 * MIB)

struct Params {
    const float* x; const float* ln_in_g; const float* ln_in_b; const float* w_in; const float* w_gate; const float* b_gate;
    const float* w_br_ret; const float* w_br_nat; const float* w_br_hgrn; const float* w_br_diff; const float* w_out;
    const float* ret_gn; const float* nat_rpb; const float* hgrn_lb; const float* hgrn_gn; const float* diff_lambda; const float* diff_subln;
    const float* ln1_g; const float* ln1_b; const float* w_router; const float* router_bias;
    const float* w_e_gate; const float* w_e_up; const float* w_e_down; const float* w_s_gate; const float* w_s_up; const float* w_s_down;
    const float* ln2_g; const float* ln2_b;
    float* out; unsigned char* ws;
    int ph_lo, ph_hi;
};

#define XB_TMO      128
#define XB_XCNT(j)  (256  + 64 * (j))
#define XB_XSUB(j)  (1280 + 64 * (j))
#define XB_XGEN(j)  (2304 + 64 * (j))
#define XB_TOP      3328
#define XB_TOPGEN   3392
#define XCD_BAR_WORDS 3456
#define XB_SPIN_CAP (1u << 27)
#define LAS __attribute__((address_space(3)))

__device__ __forceinline__ unsigned xb_ld(unsigned* p)              { return __hip_atomic_load(p, __ATOMIC_RELAXED, __HIP_MEMORY_SCOPE_AGENT); }
__device__ __forceinline__ unsigned xb_add(unsigned* p, unsigned v) { return __hip_atomic_fetch_add(p, v, __ATOMIC_RELAXED, __HIP_MEMORY_SCOPE_AGENT); }
__device__ __forceinline__ unsigned xb_xcc_id() { return (unsigned)__builtin_amdgcn_s_getreg((3 << 11) | 20) & 0xFu; }
#define XB_SPIN(cond, bar) do { unsigned _sp = 0; while (cond) { __builtin_amdgcn_s_sleep(1); \
    if ((++_sp & 255u) == 0u) { if (xb_ld(&(bar)[XB_TMO])) break; if (_sp > XB_SPIN_CAP) { atomicAdd(&(bar)[XB_TMO], 1u); break; } } } } while (0)

struct XcdBarrier { unsigned* bar; unsigned x; volatile LAS unsigned* st; };

__device__ __forceinline__ XcdBarrier xcd_barrier_post(unsigned* bar, volatile LAS unsigned* st) {
    XcdBarrier b; b.bar = bar; b.x = xb_xcc_id(); b.st = st;
    if (threadIdx.x == 0) (void)xb_add(&bar[XB_XCNT(b.x)], 1u);
    return b;
}
__device__ __forceinline__ void xcd_barrier_complete(unsigned* bar, unsigned x, unsigned& nloc, unsigned& nx) {
    const unsigned G = gridDim.x * gridDim.y * gridDim.z;
    unsigned sum, cnt, mine, sp = 0u;
    for (;;) {
        sum = 0u; cnt = 0u; mine = 0u;
#pragma unroll
        for (unsigned j = 0; j < 16; ++j) { const unsigned c = xb_ld(&bar[XB_XCNT(j)]); sum += c; cnt += (c > 0u) ? 1u : 0u; mine = (j == x) ? c : mine; }
        if (sum == G) break;
        __builtin_amdgcn_s_sleep(1);
        if ((++sp & 255u) == 0u) { if (xb_ld(&bar[XB_TMO])) break; if (sp > XB_SPIN_CAP) { atomicAdd(&bar[XB_TMO], 1u); break; } }
    }
    nloc = mine > 0u ? mine : 1u; nx = cnt > 0u ? cnt : 1u;
}
__device__ __forceinline__ void xcd_barrier(const XcdBarrier& b) {
    asm volatile("s_waitcnt vmcnt(0)" ::: "memory");
    __syncthreads();
    if (threadIdx.x == 0) {
        unsigned* bar = b.bar;
        __builtin_amdgcn_s_waitcnt(0);
        unsigned nloc = b.st[0], nx = b.st[1];
        if (nloc == 0u) { xcd_barrier_complete(bar, b.x, nloc, nx); b.st[0] = nloc; b.st[1] = nx; }
        const unsigned old = xb_add(&bar[XB_XSUB(b.x)], 1u);
        const unsigned gen = old / nloc;
        if (old + 1u == (gen + 1u) * nloc) {
            __builtin_amdgcn_fence(__ATOMIC_RELEASE, "agent");
            asm volatile("s_waitcnt vmcnt(0)" ::: "memory");
            const unsigned og = xb_add(&bar[XB_TOP], 1u);
            const unsigned tg = og / nx;
            if (og + 1u == (tg + 1u) * nx) xb_add(&bar[XB_TOPGEN], 1u);
            else XB_SPIN(xb_ld(&bar[XB_TOPGEN]) == tg, bar);
            __builtin_amdgcn_fence(__ATOMIC_ACQUIRE, "agent");
            xb_add(&bar[XB_XGEN(b.x)], 1u);
            asm volatile("s_waitcnt vmcnt(0)" ::: "memory");
        } else {
            XB_SPIN(xb_ld(&bar[XB_XGEN(b.x)]) == gen, bar);
            __builtin_amdgcn_fence(__ATOMIC_ACQUIRE, "agent");
            asm volatile("s_waitcnt vmcnt(0)" ::: "memory");
        }
    }
    __syncthreads();
}

__device__ __forceinline__ float bf2f(bf16_t b) { return __uint_as_float(((unsigned)b) << 16); }
__device__ __forceinline__ bf16_t f2bf(float f) { unsigned u = __float_as_uint(f); u += 0x7FFFu + ((u >> 16) & 1u); return (bf16_t)(u >> 16); }
__device__ __forceinline__ float lo_bf(unsigned w) { return __uint_as_float(w << 16); }
__device__ __forceinline__ float hi_bf(unsigned w) { return __uint_as_float(w & 0xFFFF0000u); }
__device__ __forceinline__ float sigmoidf_(float v) { return 1.0f / (1.0f + __expf(-v)); }
__device__ __forceinline__ float siluf_(float v) { return v / (1.0f + __expf(-v)); }
__device__ __forceinline__ float wave_sum(float v) {
#pragma unroll
    for (int o = 32; o > 0; o >>= 1) v += __shfl_xor(v, o);
    return v;
}
__device__ __forceinline__ float dot_bf16(const bf16_t* a, const bf16_t* b, int K) {
    float s = 0.f;
    for (int k = 0; k < K; k += 8) {
        const uint4 va = *(const uint4*)(a + k), vb = *(const uint4*)(b + k);
        s += lo_bf(va.x) * lo_bf(vb.x) + hi_bf(va.x) * hi_bf(vb.x) + lo_bf(va.y) * lo_bf(vb.y) + hi_bf(va.y) * hi_bf(vb.y)
           + lo_bf(va.z) * lo_bf(vb.z) + hi_bf(va.z) * hi_bf(vb.z) + lo_bf(va.w) * lo_bf(vb.w) + hi_bf(va.w) * hi_bf(vb.w);
    }
    return s;
}

#define GTID ((int)(blockIdx.x * NTHREADS + threadIdx.x))
#define GSIZE ((int)(gridDim.x * NTHREADS))

__device__ __forceinline__ void tconv_tile(const float* src, int lds_, int sk0, int sc0, bf16_t* dst, int ldd, int dn0, int dk0, bf16_t* tile) {
    const int t = threadIdx.x;
#pragma unroll
    for (int i = 0; i < 2; ++i) {
        const int row = (t >> 4) + 32 * i, c4 = (t & 15) * 4;
        const float4 v = *(const float4*)(src + (size_t)(sk0 + row) * lds_ + sc0 + c4);
        tile[(c4 + 0) * 72 + row] = f2bf(v.x); tile[(c4 + 1) * 72 + row] = f2bf(v.y); tile[(c4 + 2) * 72 + row] = f2bf(v.z); tile[(c4 + 3) * 72 + row] = f2bf(v.w);
    }
    __syncthreads();
    { const int n = t >> 3, ch = t & 7;
      const uint4 w = *(const uint4*)&tile[n * 72 + ch * 8];
      *(uint4*)(dst + (size_t)(dn0 + n) * ldd + dk0 + ch * 8) = w; }
    __syncthreads();
}

__device__ void ph_conv_mixer_weights(const Params& p, int l, bf16_t* tile) {
    bf16_t* wtig = (bf16_t*)(p.ws + OFF_WTIG); bf16_t* wtbr = (bf16_t*)(p.ws + OFF_WTBR); bf16_t* wtout = (bf16_t*)(p.ws + OFF_WTOUT);
    const int n_in = 1152, n_gate = 1024, n_br = 64, n_bd = 128, n_out = 256;
    const int total = n_in + n_gate + 3 * n_br + n_bd + n_out;
    for (int j = blockIdx.x; j < total; j += gridDim.x) {
        int q = j;
        if (q < n_in) { const int kt = q & 15, nt = q >> 4; tconv_tile(p.w_in + (size_t)l * DM * INW, INW, kt * 64, nt * 64, wtig, DM, nt * 64, kt * 64, tile); continue; }
        q -= n_in;
        if (q < n_gate) { const int kt = q & 15, nt = q >> 4; tconv_tile(p.w_gate + (size_t)l * DM * 4096, 4096, kt * 64, nt * 64, wtig, DM, INW + nt * 64, kt * 64, tile); continue; }
        q -= n_gate;
        if (q < 3 * n_br) { const int which = q / n_br, r = q % n_br, kt = r & 3, nt = r >> 2;
            const float* src = (which == 0 ? p.w_br_ret : which == 1 ? p.w_br_nat : p.w_br_hgrn) + (size_t)l * 256 * DM;
            tconv_tile(src, DM, kt * 64, nt * 64, wtbr, 1280, nt * 64, which * 256 + kt * 64, tile); continue; }
        q -= 3 * n_br;
        if (q < n_bd) { const int kt = q & 7, nt = q >> 3; tconv_tile(p.w_br_diff + (size_t)l * 512 * DM, DM, kt * 64, nt * 64, wtbr, 1280, nt * 64, 768 + kt * 64, tile); continue; }
        q -= n_bd;
        { const int kt = q & 15, nt = q >> 4; tconv_tile(p.w_out + (size_t)l * DM * DM, DM, kt * 64, nt * 64, wtout, DM, nt * 64, kt * 64, tile); }
    }
}
__device__ void ph_conv_expert_weights(const Params& p, int l, bf16_t* tile) {
    bf16_t* gu = (bf16_t*)(p.ws + OFF_EXPGU); bf16_t* dn = (bf16_t*)(p.ws + OFF_EXPDN);
    const int per_gu = 128, per_dn = 64, total = 65 * (per_gu + per_dn);
    for (int j = blockIdx.x; j < total; j += gridDim.x) {
        const int e = j / (per_gu + per_dn); int q = j % (per_gu + per_dn);
        if (q < per_gu) {
            const int kt = q & 15, nt = (q >> 4) & 1, blk = q >> 5;
            const float* src = (e < 64) ? (((blk & 1) ? p.w_e_up : p.w_e_gate) + ((size_t)l * NEXP + e) * DM * EH) : (((blk & 1) ? p.w_s_up : p.w_s_gate) + (size_t)l * DM * EH);
            tconv_tile(src, EH, kt * 64, (blk >> 1) * 128 + nt * 64, gu + (size_t)e * 512 * DM, DM, blk * 128 + nt * 64, kt * 64, tile);
        } else { q -= per_gu;
            const int kt = q & 3, nt = q >> 2;
            const float* src = (e < 64) ? (p.w_e_down + ((size_t)l * NEXP + e) * EH * DM) : (p.w_s_down + (size_t)l * EH * DM);
            tconv_tile(src, DM, kt * 64, nt * 64, dn + (size_t)e * DM * EH, EH, nt * 64, kt * 64, tile);
        }
    }
}

__device__ void ph_ln_in(const Params& p) {
    bf16_t* hb = (bf16_t*)(p.ws + OFF_HB);
    const int lane = threadIdx.x & 63, gw = GTID >> 6, nw = GSIZE >> 6;
    for (int row = gw; row < NTOK; row += nw) {
        const float* xr = p.x + (size_t)row * DM;
        float4 v[4]; float s = 0.f;
#pragma unroll
        for (int i = 0; i < 4; ++i) { v[i] = *(const float4*)(xr + i * 256 + lane * 4); s += v[i].x + v[i].y + v[i].z + v[i].w; }
        const float mu = wave_sum(s) * (1.0f / DM); float q = 0.f;
#pragma unroll
        for (int i = 0; i < 4; ++i) { v[i].x -= mu; v[i].y -= mu; v[i].z -= mu; v[i].w -= mu; q += v[i].x * v[i].x + v[i].y * v[i].y + v[i].z * v[i].z + v[i].w * v[i].w; }
        const float rs = rsqrtf(wave_sum(q) * (1.0f / DM) + LN_EPS);
#pragma unroll
        for (int i = 0; i < 4; ++i) { const int c = i * 256 + lane * 4;
            const float4 g = *(const float4*)(p.ln_in_g + c), b = *(const float4*)(p.ln_in_b + c);
            ushort4 o; o.x = f2bf(v[i].x * rs * g.x + b.x); o.y = f2bf(v[i].y * rs * g.y + b.y); o.z = f2bf(v[i].z * rs * g.z + b.z); o.w = f2bf(v[i].w * rs * g.w + b.w);
            *(ushort4*)(hb + (size_t)row * DM + c) = o; }
    }
}

__device__ void ph_inproj_naive(const Params& p, int l) {
    const bf16_t* hb = (const bf16_t*)(p.ws + OFF_HB); const bf16_t* wt = (const bf16_t*)(p.ws + OFF_WTIG);
    bf16_t* proj = (bf16_t*)(p.ws + OFF_PROJ); bf16_t* gates = (bf16_t*)(p.ws + OFF_GATES);
    const float* bg = p.b_gate + (size_t)l * 4096;
    const long total = (long)NTOK * 8704;
    for (long it = GTID; it < total; it += GSIZE) {
        const int col = (int)(it % 8704), row = (int)(it / 8704);
        const float acc = dot_bf16(hb + (size_t)row * DM, wt + (size_t)col * DM, DM);
        if (col < INW) proj[(size_t)row * INW + col] = f2bf(acc);
        else gates[(size_t)row * 4096 + (col - INW)] = f2bf(sigmoidf_(acc + bg[col - INW]));
    }
}

__device__ void ph_recur_naive(const Params& p, int l) {
    if (blockIdx.x >= 64 || threadIdx.x >= 64) return;
    const int seq = blockIdx.x, lane = threadIdx.x;
    const int m = seq >> 5, dir = (seq >> 4) & 1, b = (seq >> 2) & 3, h = seq & 3;
    const bf16_t* proj = (const bf16_t*)(p.ws + OFF_PROJ);
    float* otmp = (float*)(p.ws + OFF_OTMP) + (size_t)(m * 2 + dir) * NTOK * 256;
    float S[64];
#pragma unroll
    for (int k = 0; k < 64; ++k) S[k] = 0.f;
    const int ch = h * 64 + lane;
    float lb = 0.f;
    if (m == 1 && l == 1) { const float a0 = p.hgrn_lb[(0 * 2 + dir) * 256 + ch], a1 = p.hgrn_lb[(1 * 2 + dir) * 256 + ch]; lb = 1.0f / (1.0f + __expf(a0 - a1)); }
    const float fret = 1.0f - exp2f(-(dir ? 6.0f : 5.0f) - 2.0f * (float)h);
    for (int s = 0; s < SEQ; ++s) {
        const int tt = dir ? (SEQ - 1 - s) : s; const size_t row = (size_t)b * SEQ + tt;
        const bf16_t* pr = proj + row * INW;
        float qv, kv, vv, fv;
        if (m == 0) { qv = bf2f(pr[ch]); kv = bf2f(pr[256 + ch]) * 0.125f; vv = bf2f(pr[512 + ch]); fv = fret; }
        else { qv = siluf_(bf2f(pr[7 * 256 + ch])); const float fp = bf2f(pr[(8 + dir) * 256 + ch]);
               fv = lb + (1.0f - lb) * sigmoidf_(fp); kv = (1.0f - lb) * sigmoidf_(-fp); vv = bf2f(pr[10 * 256 + ch]); }
        float o = 0.f;
#pragma unroll
        for (int k = 0; k < 64; ++k) {
            const float fk = __int_as_float(__builtin_amdgcn_readlane(__float_as_int(fv), k));
            const float kk = __int_as_float(__builtin_amdgcn_readlane(__float_as_int(kv), k));
            const float qk = __int_as_float(__builtin_amdgcn_readlane(__float_as_int(qv), k));
            S[k] = fk * S[k] + kk * vv; o += S[k] * qk;
        }
        otmp[row * 256 + ch] = o;
    }
}
__device__ void ph_recur_finish(const Params& p, int l) {
    const bf16_t* proj = (const bf16_t*)(p.ws + OFF_PROJ); bf16_t* y = (bf16_t*)(p.ws + OFF_Y);
    const float* otmp = (const float*)(p.ws + OFF_OTMP);
    const int lane = threadIdx.x & 63, gw = GTID >> 6, nw = GSIZE >> 6;
    for (int it = gw; it < NTOK * 8; it += nw) {
        const int h = it & 3, m = (it >> 2) & 1, row = it >> 3, ch = h * 64 + lane;
        const float o = otmp[((size_t)(m * 2 + 0) * NTOK + row) * 256 + ch] + otmp[((size_t)(m * 2 + 1) * NTOK + row) * 256 + ch];
        const float ms = wave_sum(o * o) * (1.0f / 64.0f);
        const float gn = (m == 0 ? p.ret_gn : p.hgrn_gn)[(size_t)l * 256 + ch];
        const float g = bf2f(proj[(size_t)row * INW + (m == 0 ? 3 : 11) * 256 + ch]);
        y[(size_t)row * 1280 + (m == 0 ? 0 : 512) + ch] = f2bf(o * rsqrtf(ms + LN_EPS) * gn * siluf_(g));
    }
}

__device__ void ph_nat_naive(const Params& p, int l) {
    const bf16_t* proj = (const bf16_t*)(p.ws + OFF_PROJ); bf16_t* y = (bf16_t*)(p.ws + OFF_Y);
    const float* rpb = p.nat_rpb + (size_t)l * 4 * 15 * 31;
    for (int it = GTID; it < NTOK * 4; it += GSIZE) {
        const int row = it % NTOK, h = it / NTOK;
        const int b = row >> 12, r = (row >> 6) & 63, c = row & 63;
        const int rs = min(max(r - 4, 0), 56), cs = min(max(c - 8, 0), 48);
        float q[64], acc[64];
        { const bf16_t* qp = proj + (size_t)row * INW + 4 * 256 + h * 64;
#pragma unroll
          for (int d = 0; d < 64; ++d) { q[d] = bf2f(qp[d]); acc[d] = 0.f; } }
        float mx = -1e30f, lsum = 0.f;
        for (int kr = 0; kr < 8; ++kr) for (int kc = 0; kc < 16; ++kc) {
            const int rr = rs + kr, cc = cs + kc; const size_t krow = (size_t)b * SEQ + rr * 64 + cc;
            const bf16_t* kp = proj + krow * INW + 5 * 256 + h * 64; const bf16_t* vp = proj + krow * INW + 6 * 256 + h * 64;
            float s = 0.f;
#pragma unroll
            for (int d = 0; d < 64; ++d) s += q[d] * bf2f(kp[d]);
            int dc = cc - c; dc = min(max(dc, -15), 15) + 15;
            s = s * 0.125f + rpb[(h * 15 + (rr - r + 7)) * 31 + dc];
            const float mn = fmaxf(mx, s), sc = __expf(mx - mn), pe = __expf(s - mn);
            lsum = lsum * sc + pe; mx = mn;
#pragma unroll
            for (int d = 0; d < 64; ++d) acc[d] = acc[d] * sc + pe * bf2f(vp[d]);
        }
        const float inv = 1.0f / lsum;
        bf16_t* yp = y + (size_t)row * 1280 + 256 + h * 64;
#pragma unroll
        for (int d = 0; d < 64; ++d) yp[d] = f2bf(acc[d] * inv);
    }
}

__device__ void ph_diff_naive(const Params& p, int l) {
    const bf16_t* proj = (const bf16_t*)(p.ws + OFF_PROJ); bf16_t* dt = (bf16_t*)(p.ws + OFF_DTMP);
    for (int it = GTID; it < NTOK * 32; it += GSIZE) {
        const int row = it % NTOK, grp = it / NTOK;
        const int dvq = grp & 3, j = (grp >> 2) & 1, h = grp >> 3;
        const int b = row >> 12, qpos = row & 4095;
        const float slope = exp2f(-2.0f * (float)(h + 1));
        float q[64], acc[32];
        { const bf16_t* qp = proj + (size_t)row * INW + 12 * 256 + h * 128 + j * 64;
#pragma unroll
          for (int d = 0; d < 64; ++d) q[d] = bf2f(qp[d]) * 0.125f;
#pragma unroll
          for (int d = 0; d < 32; ++d) acc[d] = 0.f; }
        float mx = -1e30f, lsum = 0.f;
        for (int kpos = 0; kpos < SEQ; ++kpos) {
            const size_t krow = (size_t)b * SEQ + kpos;
            const bf16_t* kp = proj + krow * INW + 14 * 256 + h * 128 + j * 64; const bf16_t* vp = proj + krow * INW + 16 * 256 + h * 128 + dvq * 32;
            float s = 0.f;
#pragma unroll
            for (int d = 0; d < 64; d += 8) { const uint4 kv = *(const uint4*)(kp + d);
                s += q[d] * lo_bf(kv.x) + q[d + 1] * hi_bf(kv.x) + q[d + 2] * lo_bf(kv.y) + q[d + 3] * hi_bf(kv.y) + q[d + 4] * lo_bf(kv.z) + q[d + 5] * hi_bf(kv.z) + q[d + 6] * lo_bf(kv.w) + q[d + 7] * hi_bf(kv.w); }
            s -= slope * fabsf((float)(qpos - kpos));
            if (s > mx) { const float sc = __expf(mx - s); lsum *= sc;
#pragma unroll
                for (int d = 0; d < 32; ++d) acc[d] *= sc;
                mx = s; }
            const float pe = __expf(s - mx); lsum += pe;
#pragma unroll
            for (int d = 0; d < 32; d += 8) { const uint4 vv = *(const uint4*)(vp + d);
                acc[d] += pe * lo_bf(vv.x); acc[d + 1] += pe * hi_bf(vv.x); acc[d + 2] += pe * lo_bf(vv.y); acc[d + 3] += pe * hi_bf(vv.y);
                acc[d + 4] += pe * lo_bf(vv.z); acc[d + 5] += pe * hi_bf(vv.z); acc[d + 6] += pe * lo_bf(vv.w); acc[d + 7] += pe * hi_bf(vv.w); }
        }
        const float inv = 1.0f / lsum;
        bf16_t* op = dt + (((size_t)row * 4 + h) * 2 + j) * 128 + dvq * 32;
#pragma unroll
        for (int d = 0; d < 32; ++d) op[d] = f2bf(acc[d] * inv);
    }
}
__device__ void ph_diff_finish(const Params& p, int l) {
    const bf16_t* dt = (const bf16_t*)(p.ws + OFF_DTMP); bf16_t* y = (bf16_t*)(p.ws + OFF_Y);
    const int lane = threadIdx.x & 63, gw = GTID >> 6, nw = GSIZE >> 6;
    const float* lp = p.diff_lambda + (size_t)l * 256;
    const float s1 = wave_sum(lp[lane] * lp[64 + lane]), s2 = wave_sum(lp[128 + lane] * lp[192 + lane]);
    const float lam_init = 0.8f - 0.6f * __expf(-0.3f * (float)l);
    const float lam = __expf(s1) - __expf(s2) + lam_init;
    for (int it = gw; it < NTOK * 4; it += nw) {
        const int h = it & 3, row = it >> 2;
        const bf16_t* o1 = dt + (((size_t)row * 4 + h) * 2 + 0) * 128; const bf16_t* o2 = o1 + 128;
        const float a = bf2f(o1[lane]) - lam * bf2f(o2[lane]), c = bf2f(o1[64 + lane]) - lam * bf2f(o2[64 + lane]);
        const float ms = wave_sum(a * a + c * c) * (1.0f / 128.0f), rs = rsqrtf(ms + LN_EPS) * (1.0f - lam_init);
        const float* sl = p.diff_subln + (size_t)l * 512 + h * 128;
        bf16_t* yp = y + (size_t)row * 1280 + 768 + h * 128;
        yp[lane] = f2bf(a * rs * sl[lane]); yp[64 + lane] = f2bf(c * rs * sl[64 + lane]);
    }
}

__device__ void ph_merge_naive(const Params& p) {
    const bf16_t* y = (const bf16_t*)(p.ws + OFF_Y); const bf16_t* gates = (const bf16_t*)(p.ws + OFF_GATES); const bf16_t* wt = (const bf16_t*)(p.ws + OFF_WTBR);
    bf16_t* mg = (bf16_t*)(p.ws + OFF_MERGED);
    for (int it = GTID; it < NTOK * DM; it += GSIZE) {
        const int col = it & 1023, row = it >> 10;
        const bf16_t* yr = y + (size_t)row * 1280; const bf16_t* wr = wt + (size_t)col * 1280; const bf16_t* gr = gates + (size_t)row * 4096 + col;
        const float v = bf2f(gr[0]) * dot_bf16(yr, wr, 256) + bf2f(gr[1024]) * dot_bf16(yr + 256, wr + 256, 256)
                      + bf2f(gr[2048]) * dot_bf16(yr + 512, wr + 512, 256) + bf2f(gr[3072]) * dot_bf16(yr + 768, wr + 768, 512);
        mg[(size_t)row * DM + col] = f2bf(v);
    }
}
__device__ void ph_outproj_naive(const Params& p) {
    const bf16_t* mg = (const bf16_t*)(p.ws + OFF_MERGED); const bf16_t* wt = (const bf16_t*)(p.ws + OFF_WTOUT); const bf16_t* hb = (const bf16_t*)(p.ws + OFF_HB);
    bf16_t* x = (bf16_t*)(p.ws + OFF_X);
    for (int it = GTID; it < NTOK * DM; it += GSIZE) {
        const int col = it & 1023, row = it >> 10;
        x[it] = f2bf(ALPHA_F * bf2f(hb[it]) + dot_bf16(mg + (size_t)row * DM, wt + (size_t)col * DM, DM));
    }
}

__device__ void ph_ln1_route(const Params& p, int l, float* hrow_all) {
    const bf16_t* x = (const bf16_t*)(p.ws + OFF_X); bf16_t* hb = (bf16_t*)(p.ws + OFF_HB);
    int* tope = (int*)(p.ws + OFF_TOPE); float* topw = (float*)(p.ws + OFF_TOPW); int* topp = (int*)(p.ws + OFF_TOPP);
    unsigned* cnt = (unsigned*)(p.ws + OFF_CNT) + l * 64;
    const float* g1 = p.ln1_g + (size_t)l * DM; const float* b1 = p.ln1_b + (size_t)l * DM;
    const float* wr = p.w_router + (size_t)l * DM * NEXP; const float rb = p.router_bias[l * NEXP + (threadIdx.x & 63)];
    const int lane = threadIdx.x & 63, wv = threadIdx.x >> 6, gw = GTID >> 6, nw = GSIZE >> 6;
    float* hrow = hrow_all + wv * DM;
    for (int row = gw; row < NTOK; row += nw) {
        const bf16_t* xr = x + (size_t)row * DM;
        float v[16]; float s = 0.f;
#pragma unroll
        for (int i = 0; i < 4; ++i) { const ushort4 u = *(const ushort4*)(xr + i * 256 + lane * 4); v[i * 4] = bf2f(u.x); v[i * 4 + 1] = bf2f(u.y); v[i * 4 + 2] = bf2f(u.z); v[i * 4 + 3] = bf2f(u.w);
            s += v[i * 4] + v[i * 4 + 1] + v[i * 4 + 2] + v[i * 4 + 3]; }
        const float mu = wave_sum(s) * (1.0f / DM); float q = 0.f;
#pragma unroll
        for (int i = 0; i < 16; ++i) { v[i] -= mu; q += v[i] * v[i]; }
        const float rs = rsqrtf(wave_sum(q) * (1.0f / DM) + LN_EPS);
#pragma unroll
        for (int i = 0; i < 4; ++i) { const int c = i * 256 + lane * 4;
            const float4 g = *(const float4*)(g1 + c), b = *(const float4*)(b1 + c);
            float4 o; o.x = v[i * 4] * rs * g.x + b.x; o.y = v[i * 4 + 1] * rs * g.y + b.y; o.z = v[i * 4 + 2] * rs * g.z + b.z; o.w = v[i * 4 + 3] * rs * g.w + b.w;
            *(float4*)(hrow + c) = o;
            ushort4 ob; ob.x = f2bf(o.x); ob.y = f2bf(o.y); ob.z = f2bf(o.z); ob.w = f2bf(o.w);
            *(ushort4*)(hb + (size_t)row * DM + c) = ob; }
        __builtin_amdgcn_wave_barrier();
        float lg = 0.f;
        for (int k = 0; k < DM; k += 4) { const float4 hv = *(const float4*)(hrow + k);
            lg += hv.x * wr[(size_t)k * NEXP + lane]; lg += hv.y * wr[(size_t)(k + 1) * NEXP + lane]; lg += hv.z * wr[(size_t)(k + 2) * NEXP + lane]; lg += hv.w * wr[(size_t)(k + 3) * NEXP + lane]; }
        __builtin_amdgcn_wave_barrier();
        const float score = sigmoidf_(lg), biased = score + rb;
        int rk = 0;
#pragma unroll
        for (int j = 0; j < 8; ++j) { const int src = (lane & ~7) | j; const float o = __shfl(biased, src); rk += (o > biased || (o == biased && src < lane)) ? 1 : 0; }
        float gs = (rk < 2) ? biased : 0.f;
        gs += __shfl_xor(gs, 1); gs += __shfl_xor(gs, 2); gs += __shfl_xor(gs, 4);
        int grk = 0;
#pragma unroll
        for (int j = 0; j < 8; ++j) { const float o = __shfl(gs, j * 8); const int myg = lane >> 3; grk += (o > gs || (o == gs && j < myg)) ? 1 : 0; }
        const float mval = (grk < 4) ? biased : -1e30f;
        int erk = 0;
        for (int j = 0; j < 64; ++j) { const float o = __shfl(mval, j); erk += (o > mval || (o == mval && j < lane)) ? 1 : 0; }
        const bool sel = erk < 8;
        const float wsum = wave_sum(sel ? score : 0.f);
        if (sel) {
            const float w = score / (wsum + 1e-20f) * 2.5f;
            const unsigned pos = atomicAdd(&cnt[lane], 1u);
            tope[(size_t)row * 8 + erk] = lane; topw[(size_t)row * 8 + erk] = w; topp[(size_t)row * 8 + erk] = (int)pos;
        }
    }
}

__device__ void ph_hid_naive(const Params& p, int l, int* offs) {
    const bf16_t* hb = (const bf16_t*)(p.ws + OFF_HB); const bf16_t* gu = (const bf16_t*)(p.ws + OFF_EXPGU); bf16_t* hid = (bf16_t*)(p.ws + OFF_HID);
    const int* tope = (const int*)(p.ws + OFF_TOPE); const float* topw = (const float*)(p.ws + OFF_TOPW); const int* topp = (const int*)(p.ws + OFF_TOPP);
    const long total = (long)NTOK * 9 * EH;
    for (long it = GTID; it < total; it += GSIZE) {
        const int j = (int)(it & 255); const int slot = (int)(it >> 8); const int t = slot / 9, k = slot % 9;
        int e; float w; size_t orow;
        if (k < 8) { e = tope[t * 8 + k]; w = topw[t * 8 + k]; orow = (size_t)offs[e] + topp[t * 8 + k]; } else { e = 64; w = 1.0f; orow = (size_t)8 * NTOK + t; }
        const bf16_t* wg = gu + ((size_t)e * 512 + (j >> 7) * 256 + (j & 127)) * DM; const bf16_t* wu = wg + (size_t)128 * DM;
        const float g = dot_bf16(hb + (size_t)t * DM, wg, DM), u = dot_bf16(hb + (size_t)t * DM, wu, DM);
        hid[orow * EH + j] = f2bf(siluf_(g) * u * w);
    }
}
__device__ void ph_down_naive(const Params& p, int l, int* offs) {
    const bf16_t* hb = (const bf16_t*)(p.ws + OFF_HB); const bf16_t* dn = (const bf16_t*)(p.ws + OFF_EXPDN); const bf16_t* hid = (const bf16_t*)(p.ws + OFF_HID);
    bf16_t* outs = (bf16_t*)(p.ws + OFF_OUTS); bf16_t* x = (bf16_t*)(p.ws + OFF_X);
    const long total = (long)NTOK * 9 * DM;
    for (long it = GTID; it < total; it += GSIZE) {
        const int n = (int)(it & 1023); const int row = (int)(it >> 10);
        if (row < 8 * NTOK) { int e = 0;
            for (int q = 1; q < 64; ++q) e += (row >= offs[q]) ? 1 : 0;
            outs[(size_t)row * DM + n] = f2bf(dot_bf16(hid + (size_t)row * EH, dn + ((size_t)e * DM + n) * EH, EH));
        } else { const int t = row - 8 * NTOK;
            x[(size_t)t * DM + n] = f2bf(ALPHA_F * bf2f(hb[(size_t)t * DM + n]) + dot_bf16(hid + (size_t)row * EH, dn + ((size_t)64 * DM + n) * EH, EH)); }
    }
}
__device__ void ph_combine_ln2(const Params& p, int l, int* offs) {
    const bf16_t* x = (const bf16_t*)(p.ws + OFF_X); const bf16_t* outs = (const bf16_t*)(p.ws + OFF_OUTS); bf16_t* hb = (bf16_t*)(p.ws + OFF_HB);
    const int* tope = (const int*)(p.ws + OFF_TOPE); const int* topp = (const int*)(p.ws + OFF_TOPP);
    const float* g2 = p.ln2_g + (size_t)l * DM; const float* b2 = p.ln2_b + (size_t)l * DM;
    const int lane = threadIdx.x & 63, gw = GTID >> 6, nw = GSIZE >> 6;
    for (int row = gw; row < NTOK; row += nw) {
        float v[16];
#pragma unroll
        for (int i = 0; i < 4; ++i) { const ushort4 u = *(const ushort4*)(x + (size_t)row * DM + i * 256 + lane * 4); v[i * 4] = bf2f(u.x); v[i * 4 + 1] = bf2f(u.y); v[i * 4 + 2] = bf2f(u.z); v[i * 4 + 3] = bf2f(u.w); }
        for (int k = 0; k < 8; ++k) { const size_t r = (size_t)offs[tope[row * 8 + k]] + topp[row * 8 + k];
#pragma unroll
            for (int i = 0; i < 4; ++i) { const ushort4 u = *(const ushort4*)(outs + r * DM + i * 256 + lane * 4); v[i * 4] += bf2f(u.x); v[i * 4 + 1] += bf2f(u.y); v[i * 4 + 2] += bf2f(u.z); v[i * 4 + 3] += bf2f(u.w); } }
        float s = 0.f;
#pragma unroll
        for (int i = 0; i < 16; ++i) s += v[i];
        const float mu = wave_sum(s) * (1.0f / DM); float q = 0.f;
#pragma unroll
        for (int i = 0; i < 16; ++i) { v[i] -= mu; q += v[i] * v[i]; }
        const float rs = rsqrtf(wave_sum(q) * (1.0f / DM) + LN_EPS);
#pragma unroll
        for (int i = 0; i < 4; ++i) { const int c = i * 256 + lane * 4;
            const float4 g = *(const float4*)(g2 + c), b = *(const float4*)(b2 + c);
            float4 o; o.x = v[i * 4] * rs * g.x + b.x; o.y = v[i * 4 + 1] * rs * g.y + b.y; o.z = v[i * 4 + 2] * rs * g.z + b.z; o.w = v[i * 4 + 3] * rs * g.w + b.w;
            if (l == NLAYER - 1) *(float4*)(p.out + (size_t)row * DM + c) = o;
            else { ushort4 ob; ob.x = f2bf(o.x); ob.y = f2bf(o.y); ob.z = f2bf(o.z); ob.w = f2bf(o.w); *(ushort4*)(hb + (size_t)row * DM + c) = ob; } }
    }
}

#define NPH 16
__global__ void __launch_bounds__(NTHREADS, 2) fwd_kernel(Params p) {
    extern __shared__ __attribute__((aligned(16))) unsigned char lds[];
    volatile LAS unsigned* xbw = (volatile LAS unsigned*)(LAS unsigned char*)lds;
    int* offs = (int*)(lds + 16);
    unsigned char* scratch = lds + 512;
    if (threadIdx.x < 4) xbw[threadIdx.x] = 0u;
    __syncthreads();
    XcdBarrier bar = xcd_barrier_post((unsigned*)(p.ws + OFF_BAR), xbw);
    const int lo = p.ph_lo, hi = p.ph_hi;
#define IN(k) (lo <= (k) && (k) < hi)
#define SEAM(k) do { if (IN(k) && IN((k) + 1)) xcd_barrier(bar); } while (0)
    for (int l = 0; l < NLAYER; ++l) {
        const int pb = l * NPH;
        if (IN(pb + 0)) { ph_conv_mixer_weights(p, l, (bf16_t*)scratch); if (l == 0) ph_ln_in(p); }
        SEAM(pb + 0);
        if (IN(pb + 1)) ph_inproj_naive(p, l);
        SEAM(pb + 1);
        if (IN(pb + 2)) { ph_recur_naive(p, l); ph_nat_naive(p, l); ph_diff_naive(p, l); }
        SEAM(pb + 2);
        if (IN(pb + 3)) { ph_recur_finish(p, l); ph_diff_finish(p, l); }
        SEAM(pb + 3);
        if (IN(pb + 4)) { ph_merge_naive(p); }
        SEAM(pb + 4);
        if (IN(pb + 5)) { ph_outproj_naive(p); ph_conv_expert_weights(p, l, (bf16_t*)scratch); }
        SEAM(pb + 5);
        if (IN(pb + 6)) ph_ln1_route(p, l, (float*)scratch);
        SEAM(pb + 6);
        if (IN(pb + 7) || IN(pb + 8) || IN(pb + 9)) {
            __syncthreads();
            if (threadIdx.x == 0) { const unsigned* cnt = (const unsigned*)(p.ws + OFF_CNT) + l * 64; int a = 0; for (int e = 0; e < 64; ++e) { offs[e] = a; a += (int)cnt[e]; } offs[64] = a; }
            __syncthreads();
        }
        if (IN(pb + 7)) ph_hid_naive(p, l, offs);
        SEAM(pb + 7);
        if (IN(pb + 8)) ph_down_naive(p, l, offs);
        SEAM(pb + 8);
        if (IN(pb + 9)) ph_combine_ln2(p, l, offs);
        SEAM(pb + 9);
    }
#undef IN
#undef SEAM
}

#define LDS_BYTES (64 * 1024)

extern "C" void kernel_launch(void* const* d_in, const int* in_sizes, int n_in, void* d_out, int out_size, void* d_ws, size_t ws_size, hipStream_t stream) {
    static int grid = 0;
    if (grid == 0) {
        if (n_in != 29 || out_size != NTOK * DM || ws_size < WS_END) { fprintf(stderr, "kernel_launch: unexpected shapes (n_in %d out %d ws %zu need %zu)\n", n_in, out_size, ws_size, (size_t)WS_END); grid = -1; return; }
        int dev = 0, cus = 0, per_cu = 0;
        if (hipGetDevice(&dev) != hipSuccess || hipDeviceGetAttribute(&cus, hipDeviceAttributeMultiprocessorCount, dev) != hipSuccess) { grid = -1; return; }
        if (hipFuncSetAttribute((const void*)fwd_kernel, hipFuncAttributeMaxDynamicSharedMemorySize, LDS_BYTES) != hipSuccess) { grid = -1; return; }
        if (hipOccupancyMaxActiveBlocksPerMultiprocessor(&per_cu, (const void*)fwd_kernel, NTHREADS, LDS_BYTES) != hipSuccess || per_cu < 1) { fprintf(stderr, "occupancy query: %d\n", per_cu); }
        (void)hipGetLastError();
        grid = cus;
    }
    if (grid < 0) return;
    hipMemsetAsync((char*)d_ws, 0, CTL_ZERO_BYTES, stream);
    Params p{};
    const float** pp = (const float**)&p;
    for (int i = 0; i < 29; ++i) pp[i] = (const float*)d_in[i];
    p.out = (float*)d_out; p.ws = (unsigned char*)d_ws; p.ph_lo = 0; p.ph_hi = NLAYER * NPH;
    hipLaunchKernelGGL(fwd_kernel, dim3(grid), dim3(NTHREADS), LDS_BYTES, stream, p);
}
```

```cpp
#include <hip/hip_runtime.h>
#include <stdint.h>
#include <stdio.h>
#ifndef FAST_MASK
#define FAST_MASK 0xff
#endif

typedef unsigned short bf16_t;
typedef unsigned int u32;

#define NTOK 16384
#define SEQ 4096
#define DM 1024
#define INW 4608
#define NLAYER 2
#define NEXP 64
#define EH 256
#define ALPHA_F 1.41421356237309515f
#define LN_EPS 1e-5f
#define NTHREADS 512

#define MIB ((size_t)1 << 20)
#define OFF_BAR   ((size_t)0)
#define OFF_CNT   ((size_t)16384)
#define CTL_ZERO_BYTES ((size_t)32768)
#define OFF_WTIG  (1 * MIB)
#define OFF_WTBR  (18 * MIB)
#define OFF_WTOUT (OFF_WTBR + 2560 * 1024)
#define OFF_HB    (23 * MIB)
#define OFF_X     (55 * MIB)
#define OFF_EXPW  (87 * MIB)
#define OFF_EXPGU OFF_EXPW
#define OFF_EXPDN (OFF_EXPW + 65 * MIB)
#define OFF_OTMP  OFF_EXPW
#define OFF_ROUTE (185 * MIB)
#define OFF_TOPE  OFF_ROUTE
#define OFF_TOPW  (OFF_ROUTE + 512 * 1024)
#define OFF_TOPP  (OFF_ROUTE + 1024 * 1024)
#define OFF_PERM  (OFF_ROUTE + 1536 * 1024)
#define OFF_R     (191 * MIB)
#define OFF_PROJ  OFF_R
#define OFF_GATES (OFF_R + 144 * MIB)
#define OFF_Y     (OFF_R + 272 * MIB)
#define OFF_MERGED OFF_R
#define OFF_HID   OFF_R
#define OFF_OUTS  (OFF_R + 72 * MIB)
#define OFF_DTMP  OFF_X
#define WS_END    (OFF_R + 328 * MIB)

struct Params {
    const float* x; const float* ln_in_g; const float* ln_in_b; const float* w_in; const float* w_gate; const float* b_gate;
    const float* w_br_ret; const float* w_br_nat; const float* w_br_hgrn; const float* w_br_diff; const float* w_out;
    const float* ret_gn; const float* nat_rpb; const float* hgrn_lb; const float* hgrn_gn; const float* diff_lambda; const float* diff_subln;
    const float* ln1_g; const float* ln1_b; const float* w_router; const float* router_bias;
    const float* w_e_gate; const float* w_e_up; const float* w_e_down; const float* w_s_gate; const float* w_s_up; const float* w_s_down;
    const float* ln2_g; const float* ln2_b;
    float* out; unsigned char* ws;
    int ph_lo, ph_hi;
};

#define XB_TMO      128
#define XB_XCNT(j)  (256  + 64 * (j))
#define XB_XSUB(j)  (1280 + 64 * (j))
#define XB_XGEN(j)  (2304 + 64 * (j))
#define XB_TOP      3328
#define XB_TOPGEN   3392
#define XCD_BAR_WORDS 3456
#define XB_SPIN_CAP (1u << 27)
#define LAS __attribute__((address_space(3)))

__device__ __forceinline__ unsigned xb_ld(unsigned* p)              { return __hip_atomic_load(p, __ATOMIC_RELAXED, __HIP_MEMORY_SCOPE_AGENT); }
__device__ __forceinline__ unsigned xb_add(unsigned* p, unsigned v) { return __hip_atomic_fetch_add(p, v, __ATOMIC_RELAXED, __HIP_MEMORY_SCOPE_AGENT); }
__device__ __forceinline__ unsigned xb_xcc_id() { return (unsigned)__builtin_amdgcn_s_getreg((3 << 11) | 20) & 0xFu; }
#define XB_SPIN(cond, bar) do { unsigned _sp = 0; while (cond) { __builtin_amdgcn_s_sleep(1); \
    if ((++_sp & 255u) == 0u) { if (xb_ld(&(bar)[XB_TMO])) break; if (_sp > XB_SPIN_CAP) { atomicAdd(&(bar)[XB_TMO], 1u); break; } } } } while (0)

struct XcdBarrier { unsigned* bar; unsigned x; volatile LAS unsigned* st; };

__device__ __forceinline__ XcdBarrier xcd_barrier_post(unsigned* bar, volatile LAS unsigned* st) {
    XcdBarrier b; b.bar = bar; b.x = xb_xcc_id(); b.st = st;
    if (threadIdx.x == 0) (void)xb_add(&bar[XB_XCNT(b.x)], 1u);
    return b;
}
__device__ __forceinline__ void xcd_barrier_complete(unsigned* bar, unsigned x, unsigned& nloc, unsigned& nx) {
    const unsigned G = gridDim.x * gridDim.y * gridDim.z;
    unsigned sum, cnt, mine, sp = 0u;
    for (;;) {
        sum = 0u; cnt = 0u; mine = 0u;
#pragma unroll
        for (unsigned j = 0; j < 16; ++j) { const unsigned c = xb_ld(&bar[XB_XCNT(j)]); sum += c; cnt += (c > 0u) ? 1u : 0u; mine = (j == x) ? c : mine; }
        if (sum == G) break;
        __builtin_amdgcn_s_sleep(1);
        if ((++sp & 255u) == 0u) { if (xb_ld(&bar[XB_TMO])) break; if (sp > XB_SPIN_CAP) { atomicAdd(&bar[XB_TMO], 1u); break; } }
    }
    nloc = mine > 0u ? mine : 1u; nx = cnt > 0u ? cnt : 1u;
}
__device__ __forceinline__ void xcd_barrier(const XcdBarrier& b) {
    asm volatile("s_waitcnt vmcnt(0)" ::: "memory");
    __syncthreads();
    if (threadIdx.x == 0) {
        unsigned* bar = b.bar;
        __builtin_amdgcn_s_waitcnt(0);
        unsigned nloc = b.st[0], nx = b.st[1];
        if (nloc == 0u) { xcd_barrier_complete(bar, b.x, nloc, nx); b.st[0] = nloc; b.st[1] = nx; }
        const unsigned old = xb_add(&bar[XB_XSUB(b.x)], 1u);
        const unsigned gen = old / nloc;
        if (old + 1u == (gen + 1u) * nloc) {
            __builtin_amdgcn_fence(__ATOMIC_RELEASE, "agent");
            asm volatile("s_waitcnt vmcnt(0)" ::: "memory");
            const unsigned og = xb_add(&bar[XB_TOP], 1u);
            const unsigned tg = og / nx;
            if (og + 1u == (tg + 1u) * nx) xb_add(&bar[XB_TOPGEN], 1u);
            else XB_SPIN(xb_ld(&bar[XB_TOPGEN]) == tg, bar);
            __builtin_amdgcn_fence(__ATOMIC_ACQUIRE, "agent");
            xb_add(&bar[XB_XGEN(b.x)], 1u);
            asm volatile("s_waitcnt vmcnt(0)" ::: "memory");
        } else {
            XB_SPIN(xb_ld(&bar[XB_XGEN(b.x)]) == gen, bar);
            __builtin_amdgcn_fence(__ATOMIC_ACQUIRE, "agent");
            asm volatile("s_waitcnt vmcnt(0)" ::: "memory");
        }
    }
    __syncthreads();
}

__device__ __forceinline__ float bf2f(bf16_t b) { return __uint_as_float(((unsigned)b) << 16); }
__device__ __forceinline__ bf16_t f2bf(float f) { unsigned u = __float_as_uint(f); u += 0x7FFFu + ((u >> 16) & 1u); return (bf16_t)(u >> 16); }
__device__ __forceinline__ float lo_bf(unsigned w) { return __uint_as_float(w << 16); }
__device__ __forceinline__ float hi_bf(unsigned w) { return __uint_as_float(w & 0xFFFF0000u); }
__device__ __forceinline__ float sigmoidf_(float v) { return 1.0f / (1.0f + __expf(-v)); }
__device__ __forceinline__ float siluf_(float v) { return v / (1.0f + __expf(-v)); }
__device__ __forceinline__ float wave_sum(float v) {
#pragma unroll
    for (int o = 32; o > 0; o >>= 1) v += __shfl_xor(v, o);
    return v;
}
__device__ __forceinline__ float dot_bf16(const bf16_t* a, const bf16_t* b, int K) {
    float s = 0.f;
    for (int k = 0; k < K; k += 8) {
        const uint4 va = *(const uint4*)(a + k), vb = *(const uint4*)(b + k);
        s += lo_bf(va.x) * lo_bf(vb.x) + hi_bf(va.x) * hi_bf(vb.x) + lo_bf(va.y) * lo_bf(vb.y) + hi_bf(va.y) * hi_bf(vb.y)
           + lo_bf(va.z) * lo_bf(vb.z) + hi_bf(va.z) * hi_bf(vb.z) + lo_bf(va.w) * lo_bf(vb.w) + hi_bf(va.w) * hi_bf(vb.w);
    }
    return s;
}

#define GTID ((int)(blockIdx.x * NTHREADS + threadIdx.x))
#define GSIZE ((int)(gridDim.x * NTHREADS))

__device__ __forceinline__ void tconv_tile(const float* src, int lds_, int sk0, int sc0, bf16_t* dst, int ldd, int dn0, int dk0, bf16_t* tile) {
    const int t = threadIdx.x;
#pragma unroll
    for (int i = 0; i < 2; ++i) {
        const int row = (t >> 4) + 32 * i, c4 = (t & 15) * 4;
        const float4 v = *(const float4*)(src + (size_t)(sk0 + row) * lds_ + sc0 + c4);
        tile[(c4 + 0) * 72 + row] = f2bf(v.x); tile[(c4 + 1) * 72 + row] = f2bf(v.y); tile[(c4 + 2) * 72 + row] = f2bf(v.z); tile[(c4 + 3) * 72 + row] = f2bf(v.w);
    }
    __syncthreads();
    { const int n = t >> 3, ch = t & 7;
      const uint4 w = *(const uint4*)&tile[n * 72 + ch * 8];
      *(uint4*)(dst + (size_t)(dn0 + n) * ldd + dk0 + ch * 8) = w; }
    __syncthreads();
}


namespace g8 {
typedef short bf16x8 __attribute__((ext_vector_type(8)));
typedef float f32x4 __attribute__((ext_vector_type(4)));
typedef unsigned u32x4 __attribute__((ext_vector_type(4)));
constexpr int BM = 256, BK = 64, HALF = 128, HTB = HALF * BK * 2, STAGE_BYTES = 8 * HTB, NXCD = 8, WGM = 8;
__device__ __forceinline__ int lds_byte(int r, int c) { const int st = (r >> 4) * 2 + (c >> 5), rr = r & 15, cc = c & 31, ob = rr * 64 + cc * 2; return st * 1024 + (ob ^ (((ob >> 9) & 1) << 5)); }
__device__ __forceinline__ void stage_rc(int b, int& R, int& C) { const int st = b / 1024, sb = b % 1024, swz = sb ^ (((sb >> 9) & 1) << 5); R = (st >> 1) * 16 + swz / 64; C = (st & 1) * 32 + (swz % 64) / 2; }
__device__ __forceinline__ int perm32(int rho) { const int n = rho >> 4, i = rho & 15; return 8 * (i >> 2) + 4 * n + (i & 3); }
__device__ __forceinline__ unsigned cvt_pk_bf16(float lo, float hi) { unsigned r; asm volatile("v_cvt_pk_bf16_f32 %0, %1, %2" : "=v"(r) : "v"(lo), "v"(hi)); return r; }

struct Unit { const char* A; const char* B; int row0, col0, nvalid, e, loc0; };

struct StaticSched {
    static constexpr bool GATHER = false;
    const char* A; const char* B; int lda, ldb, K; int nM, nN, nwg, G, c;
    __device__ void init(const void* A_, int lda_, const void* B_, int ldb_, int M, int N, int K_, int G_, int c_) { A = (const char*)A_; B = (const char*)B_; lda = lda_; ldb = ldb_; K = K_; nM = M / BM; nN = N / BM; nwg = nM * nN; G = G_; c = c_; }
    __device__ __forceinline__ bool next(int i, Unit& u) const {
        const long L = (long)i * G + c; if (L >= nwg) return false;
        int wgid = (int)L; { const int q = nwg / NXCD, r = nwg % NXCD, xcd = wgid % NXCD, off = wgid / NXCD; wgid = (xcd < r ? xcd * (q + 1) : r * (q + 1) + (xcd - r) * q) + off; }
        const int nig = WGM * nN, gid = wgid / nig, fm = gid * WGM, gsz = (nM - fm) < WGM ? (nM - fm) : WGM;
        const int pm = fm + ((wgid % nig) % gsz), pn = (wgid % nig) / gsz;
        u.row0 = pm * BM; u.col0 = pn * BM; u.nvalid = BM; u.e = 0; u.loc0 = 0;
        u.A = A + (size_t)u.row0 * lda * 2; u.B = B + (size_t)u.col0 * ldb * 2; return true;
    }
    __device__ __forceinline__ void gather(const Unit&, int, int, unsigned&, unsigned&) const {}
};
template <bool GATHER_> struct GroupSched {
    static constexpr bool GATHER = GATHER_;
    const char* A; const char* B; size_t bstride; int lda, ldb, K; const LAS int* offs; const LAS int* tp; const int* perm; int NC, G, c;
    __device__ __forceinline__ bool next(int i, Unit& u) const {
        const int L = i * G + c; const int total = tp[65] * NC; if (L >= total) return false;
        const int tl = L / NC, ct = L - tl * NC; const int lane = threadIdx.x & 63;
        int e = (int)__builtin_popcountll(__ballot(tp[lane] <= tl)) - 1; if (tl >= tp[64]) e = 64;
        e = __builtin_amdgcn_readfirstlane(e);
        const int rt = tl - tp[e], cnt = offs[e + 1] - offs[e];
        u.e = e; u.loc0 = rt * BM; u.row0 = offs[e] + rt * BM; u.nvalid = (cnt - rt * BM) < BM ? (cnt - rt * BM) : BM; u.col0 = ct * BM;
        u.B = B + (size_t)e * bstride + (size_t)u.col0 * ldb * 2;
        u.A = GATHER ? A : A + (size_t)u.row0 * lda * 2; return true;
    }
    __device__ __forceinline__ void gather(const Unit& u, int R, int C, unsigned& o0, unsigned& o1) const {
        const int r0 = R < u.nvalid ? R : 0, r1 = (128 + R) < u.nvalid ? (128 + R) : 0;
        const int p0 = u.loc0 + r0, p1 = u.loc0 + r1;
        const int t0 = (u.e < 64) ? perm[u.e * NTOK + p0] : p0, t1 = (u.e < 64) ? perm[u.e * NTOK + p1] : p1;
        o0 = (unsigned)(t0 * lda + C) * 2u; o1 = (unsigned)(t1 * lda + C) * 2u;
    }
};

template <class Epi, class Sched>
__device__ __forceinline__ void gemm_stream(LAS unsigned char* lds, const Sched& S, const Epi& E) {
    int tid_ = threadIdx.x; asm volatile("" : "+v"(tid_));
    const int tid = tid_, wid = __builtin_amdgcn_readfirstlane(tid >> 6), lane = tid & 63, wr = wid >> 2, wc = wid & 3, fr = lane & 15, fq = lane >> 4;
    const int nt = S.K / BK, lda = S.lda, ldb = S.ldb;
    unsigned voffA0[2], voffA1[2], voffB[2]; int RR[2], CC[2];
#pragma unroll
    for (int i = 0; i < 2; ++i) { int R, C; stage_rc(tid * 16 + i * 8192, R, C); const int Rb = Epi::PERM ? ((R & ~31) + perm32(R & 31)) : R; RR[i] = R; CC[i] = C;
        voffA0[i] = (unsigned)(R * lda + C) * 2u; voffA1[i] = voffA0[i] + (unsigned)(HALF * lda) * 2u; voffB[i] = (unsigned)(Rb * ldb + C) * 2u; }
    const size_t kstep = (size_t)(BK * 2);
    const size_t hstepB = (size_t)HALF * ldb * 2;
    const unsigned ldsw = (unsigned)wid * 1024u;
    const int aoff = lds_byte(wr * 64 + fr, fq * 8), boff = lds_byte(wc * 32 + fr, fq * 8);
#define G8_SA(b, h) (((b) * 2 + (h)) * HTB)
#define G8_SB(b, h) ((4 + (b) * 2 + (h)) * HTB)
#define G8_STAGE(bufoff, gbase, voff) do { _Pragma("unroll") for (int _i = 0; _i < 2; ++_i) \
        __builtin_amdgcn_global_load_lds((const unsigned*)((const char*)(gbase) + (voff)[_i]), (LAS unsigned*)(lds + (bufoff) + ldsw + _i * 8192), 16, 0, 0); } while (0)
#define G8_LDA(dst, b, h) do { _Pragma("unroll") for (int m = 0; m < 4; ++m) _Pragma("unroll") for (int k = 0; k < 2; ++k) dst[m][k] = *(const LAS bf16x8*)(lds + G8_SA(b, h) + aoff + m * 2048 + k * 1024); } while (0)
#define G8_LDB(dst, b, h) do { _Pragma("unroll") for (int n = 0; n < 2; ++n) _Pragma("unroll") for (int k = 0; k < 2; ++k) dst[n][k] = *(const LAS bf16x8*)(lds + G8_SB(b, h) + boff + n * 2048 + k * 1024); } while (0)
#define G8_MMA(ai, bj, At, Bt) do { __builtin_amdgcn_s_setprio(1); _Pragma("unroll") for (int m = 0; m < 4; ++m) _Pragma("unroll") for (int n = 0; n < 2; ++n) _Pragma("unroll") for (int k = 0; k < 2; ++k) \
        acc[ai][bj][m][n] = __builtin_amdgcn_mfma_f32_16x16x32_bf16(Bt[n][k], At[m][k], acc[ai][bj][m][n], 0, 0, 0); __builtin_amdgcn_s_setprio(0); } while (0)
#define G8_WAIT_V(n) asm volatile("s_waitcnt vmcnt(" #n ")" ::: "memory")
#define G8_WAIT_L(n) asm volatile("s_waitcnt lgkmcnt(" #n ")" ::: "memory")
#define G8_BAR __builtin_amdgcn_s_barrier()
#define G8_SCHED __builtin_amdgcn_sched_barrier(0)
    Unit cur, nxt; int ui = 0;
    if (!S.next(0, cur)) return;
    if (Sched::GATHER) {
#pragma unroll
        for (int i = 0; i < 2; ++i) S.gather(cur, RR[i], CC[i], voffA0[i], voffA1[i]);
    }
    f32x4 acc[2][2][4][2];
#pragma unroll
    for (int a = 0; a < 2; ++a)
#pragma unroll
        for (int b = 0; b < 2; ++b)
#pragma unroll
            for (int m = 0; m < 4; ++m)
#pragma unroll
                for (int n = 0; n < 2; ++n) acc[a][b][m][n] = (f32x4){0.f, 0.f, 0.f, 0.f};
    bf16x8 At[4][2], B0[2][2], B1[2][2];
    const char* cA = cur.A; const char* cB = cur.B;
    G8_STAGE(G8_SB(0, 0), cB, voffB); G8_STAGE(G8_SA(0, 0), cA, voffA0); G8_STAGE(G8_SB(0, 1), cB + hstepB, voffB); G8_STAGE(G8_SA(0, 1), cA, voffA1);
    if (wr == 1) G8_BAR;
    G8_WAIT_V(4); G8_BAR;
    G8_STAGE(G8_SB(1, 0), cB + kstep, voffB); G8_STAGE(G8_SA(1, 0), cA + kstep, voffA0); G8_STAGE(G8_SB(1, 1), cB + hstepB + kstep, voffB);
    G8_WAIT_V(6); G8_BAR;
    for (;;) {
        const bool has_next = S.next(ui + 1, nxt);
        const char* nA = has_next ? nxt.A : cA; const char* nB = has_next ? nxt.B : cB;
        unsigned nvA0[2], nvA1[2];
        if (Sched::GATHER) {
#pragma unroll
            for (int i = 0; i < 2; ++i) { nvA0[i] = voffA0[i]; nvA1[i] = voffA1[i]; if (has_next) S.gather(nxt, RR[i], CC[i], nvA0[i], nvA1[i]); }
        }
        for (int t = 0; t < nt; t += 2) {
            const bool last = (t == nt - 2);
            const char* a1 = cA + (size_t)(t + 1) * kstep;
            const char* a2 = last ? nA : cA + (size_t)(t + 2) * kstep; const char* b2 = last ? nB : cB + (size_t)(t + 2) * kstep;
            const char* a3 = a2 + kstep; const char* b3 = b2 + kstep;
            G8_LDB(B0, 0, 0); G8_SCHED; G8_LDA(At, 0, 0); G8_STAGE(G8_SA(1, 1), a1, voffA1);
            if (Sched::GATHER) { if (last) {
#pragma unroll
                for (int i = 0; i < 2; ++i) { voffA0[i] = nvA0[i]; voffA1[i] = nvA1[i]; } } }
            G8_WAIT_L(8); G8_BAR; G8_WAIT_L(0); G8_MMA(0, 0, At, B0); G8_BAR; G8_SCHED;
            G8_LDB(B1, 0, 1); G8_STAGE(G8_SB(0, 0), b2, voffB);
            G8_BAR; G8_WAIT_L(0); G8_MMA(0, 1, At, B1); G8_BAR;
            G8_LDA(At, 0, 1); G8_STAGE(G8_SA(0, 0), a2, voffA0);
            G8_BAR; G8_WAIT_L(0); G8_MMA(1, 0, At, B0); G8_BAR; G8_SCHED;
            G8_STAGE(G8_SB(0, 1), b2 + hstepB, voffB);
            G8_WAIT_V(6); G8_BAR; G8_MMA(1, 1, At, B1); G8_BAR;
            G8_LDB(B0, 1, 0); G8_SCHED; G8_LDA(At, 1, 0); G8_STAGE(G8_SA(0, 1), a2, voffA1);
            G8_WAIT_L(8); G8_BAR; G8_WAIT_L(0); G8_MMA(0, 0, At, B0); G8_BAR; G8_SCHED;
            G8_LDB(B1, 1, 1); G8_STAGE(G8_SB(1, 0), b3, voffB);
            G8_BAR; G8_WAIT_L(0); G8_MMA(0, 1, At, B1); G8_BAR;
            G8_LDA(At, 1, 1); G8_STAGE(G8_SA(1, 0), a3, voffA0);
            G8_BAR; G8_WAIT_L(0); G8_MMA(1, 0, At, B0); G8_BAR; G8_SCHED;
            G8_STAGE(G8_SB(1, 1), b3 + hstepB, voffB);
            G8_WAIT_V(6); G8_BAR; G8_MMA(1, 1, At, B1); G8_BAR;
        }
        E(acc, cur, wr, wc, fr, fq);
        if (!has_next) break;
#pragma unroll
        for (int a = 0; a < 2; ++a)
#pragma unroll
            for (int b = 0; b < 2; ++b)
#pragma unroll
                for (int m = 0; m < 4; ++m)
#pragma unroll
                    for (int n = 0; n < 2; ++n) acc[a][b][m][n] = (f32x4){0.f, 0.f, 0.f, 0.f};
        cur = nxt; cA = nA; cB = nB; ++ui;
    }
    G8_WAIT_V(0);
    if (wr == 0) G8_BAR;
    G8_BAR;
#undef G8_SA
#undef G8_SB
#undef G8_STAGE
#undef G8_LDA
#undef G8_LDB
#undef G8_MMA
#undef G8_WAIT_V
#undef G8_WAIT_L
#undef G8_BAR
#undef G8_SCHED
}

__device__ __forceinline__ u32x4 pack8(const f32x4& v0, const f32x4& v1) { u32x4 w; w.x = cvt_pk_bf16(v0[0], v0[1]); w.y = cvt_pk_bf16(v0[2], v0[3]); w.z = cvt_pk_bf16(v1[0], v1[1]); w.w = cvt_pk_bf16(v1[2], v1[3]); return w; }
__device__ __forceinline__ void unpack8(const u32x4& w, f32x4& v0, f32x4& v1) { v0[0] = lo_bf(w.x); v0[1] = hi_bf(w.x); v0[2] = lo_bf(w.y); v0[3] = hi_bf(w.y); v1[0] = lo_bf(w.z); v1[1] = hi_bf(w.z); v1[2] = lo_bf(w.w); v1[3] = hi_bf(w.w); }
__device__ __forceinline__ f32x4 sig4(const f32x4& v) { f32x4 r; for (int j = 0; j < 4; ++j) r[j] = __builtin_amdgcn_rcpf(1.0f + __expf(-v[j])); return r; }

struct EpiInGate {
    static constexpr bool PERM = true;
    bf16_t* proj; bf16_t* gates; const float* bias;
    __device__ __forceinline__ void operator()(const f32x4 (&acc)[2][2][4][2], const Unit& u, int wr, int wc, int fr, int fq) const {
        const bool isg = u.col0 >= INW; const int colt = isg ? u.col0 - INW : u.col0; const int ldc = isg ? 4096 : INW; bf16_t* base = isg ? gates : proj;
        const int row0 = u.row0 + wr * 64 + fr, col0 = colt + wc * 32 + 8 * fq;
        f32x4 bv[2][2];
#pragma unroll
        for (int bj = 0; bj < 2; ++bj)
#pragma unroll
            for (int n = 0; n < 2; ++n) bv[bj][n] = isg ? *(const f32x4*)(bias + col0 + bj * HALF + 4 * n) : (f32x4){0.f, 0.f, 0.f, 0.f};
#pragma unroll
        for (int ai = 0; ai < 2; ++ai)
#pragma unroll
            for (int m = 0; m < 4; ++m) { bf16_t* rowp = base + (size_t)(row0 + ai * HALF + m * 16) * ldc + col0;
#pragma unroll
                for (int bj = 0; bj < 2; ++bj) { f32x4 v0 = acc[ai][bj][m][0] + bv[bj][0], v1 = acc[ai][bj][m][1] + bv[bj][1];
                    if (isg) { v0 = sig4(v0); v1 = sig4(v1); }
                    *(u32x4*)(rowp + bj * HALF) = pack8(v0, v1); } }
    }
};
struct EpiMerge {
    static constexpr bool PERM = true;
    bf16_t* merged; const bf16_t* gates; int b;
    __device__ __forceinline__ void operator()(const f32x4 (&acc)[2][2][4][2], const Unit& u, int wr, int wc, int fr, int fq) const {
        const int row0 = u.row0 + wr * 64 + fr, col0 = u.col0 + wc * 32 + 8 * fq;
#pragma unroll
        for (int ai = 0; ai < 2; ++ai)
#pragma unroll
            for (int m = 0; m < 4; ++m) { const size_t row = (size_t)(row0 + ai * HALF + m * 16);
#pragma unroll
                for (int bj = 0; bj < 2; ++bj) { const int col = col0 + bj * HALF;
                    const u32x4 gw = *(const u32x4*)(gates + row * 4096 + b * 1024 + col); f32x4 g0, g1; unpack8(gw, g0, g1);
                    f32x4 v0 = acc[ai][bj][m][0] * g0, v1 = acc[ai][bj][m][1] * g1;
                    if (b > 0) { const u32x4 mw = *(const u32x4*)(merged + row * DM + col); f32x4 m0, m1; unpack8(mw, m0, m1); v0 += m0; v1 += m1; }
                    *(u32x4*)(merged + row * DM + col) = pack8(v0, v1); } }
    }
};
struct EpiResid {
    static constexpr bool PERM = true;
    bf16_t* x; const bf16_t* hb;
    __device__ __forceinline__ void operator()(const f32x4 (&acc)[2][2][4][2], const Unit& u, int wr, int wc, int fr, int fq) const {
        const int row0 = u.row0 + wr * 64 + fr, col0 = u.col0 + wc * 32 + 8 * fq;
#pragma unroll
        for (int ai = 0; ai < 2; ++ai)
#pragma unroll
            for (int m = 0; m < 4; ++m) { const size_t row = (size_t)(row0 + ai * HALF + m * 16);
#pragma unroll
                for (int bj = 0; bj < 2; ++bj) { const int col = col0 + bj * HALF;
                    const u32x4 hw = *(const u32x4*)(hb + row * DM + col); f32x4 h0, h1; unpack8(hw, h0, h1);
                    *(u32x4*)(x + row * DM + col) = pack8(acc[ai][bj][m][0] + h0 * ALPHA_F, acc[ai][bj][m][1] + h1 * ALPHA_F); } }
    }
};
struct EpiGateUp {
    static constexpr bool PERM = true;
    bf16_t* hid;
    __device__ __forceinline__ void operator()(const f32x4 (&acc)[2][2][4][2], const Unit& u, int wr, int wc, int fr, int fq) const {
        const int hc = (u.col0 >> 1) + wc * 32 + 8 * fq;
#pragma unroll
        for (int ai = 0; ai < 2; ++ai)
#pragma unroll
            for (int m = 0; m < 4; ++m) { const int rl = ai * HALF + wr * 64 + m * 16 + fr;
                if (rl < u.nvalid) { f32x4 v0, v1;
#pragma unroll
                    for (int j = 0; j < 4; ++j) { const float g0 = acc[ai][0][m][0][j], g1 = acc[ai][0][m][1][j];
                        v0[j] = g0 * __builtin_amdgcn_rcpf(1.0f + __expf(-g0)) * acc[ai][1][m][0][j]; v1[j] = g1 * __builtin_amdgcn_rcpf(1.0f + __expf(-g1)) * acc[ai][1][m][1][j]; }
                    *(u32x4*)(hid + (size_t)(u.row0 + rl) * EH + hc) = pack8(v0, v1); } }
    }
};
struct EpiDown {
    static constexpr bool PERM = true;
    bf16_t* outs; bf16_t* x; const bf16_t* hb;
    __device__ __forceinline__ void operator()(const f32x4 (&acc)[2][2][4][2], const Unit& u, int wr, int wc, int fr, int fq) const {
        const int col0 = u.col0 + wc * 32 + 8 * fq;
#pragma unroll
        for (int ai = 0; ai < 2; ++ai)
#pragma unroll
            for (int m = 0; m < 4; ++m) { const int rl = ai * HALF + wr * 64 + m * 16 + fr;
                if (rl < u.nvalid) { const size_t row = (size_t)(u.row0 + rl);
#pragma unroll
                    for (int bj = 0; bj < 2; ++bj) { const int col = col0 + bj * HALF;
                        if (u.e < 64) *(u32x4*)(outs + row * DM + col) = pack8(acc[ai][bj][m][0], acc[ai][bj][m][1]);
                        else { const size_t t = row - (size_t)8 * NTOK; const u32x4 hw = *(const u32x4*)(hb + t * DM + col); f32x4 h0, h1; unpack8(hw, h0, h1);
                            *(u32x4*)(x + t * DM + col) = pack8(acc[ai][bj][m][0] + h0 * ALPHA_F, acc[ai][bj][m][1] + h1 * ALPHA_F); } } } }
    }
};
}


namespace att {
typedef short bf16x8 __attribute__((ext_vector_type(8)));
typedef short s16x4 __attribute__((ext_vector_type(4)));
typedef float f32x16 __attribute__((ext_vector_type(16)));
typedef float f32x4 __attribute__((ext_vector_type(4)));
constexpr int KBUF = 8192, VBUF = 16384, TBUF = KBUF + VBUF;
constexpr int RPB_OFF = 2 * TBUF;
constexpr float LOG2E = 1.4426950408889634f;
#define ATT_TR(dst, addr, OFF) asm volatile("ds_read_b64_tr_b16 %0, %1 offset:%2" : "=&v"(dst) : "v"(addr), "i"(OFF) : "memory")
__device__ __forceinline__ unsigned pk2(float a, float b) { unsigned r; asm volatile("v_cvt_pk_bf16_f32 %0, %1, %2" : "=v"(r) : "v"(a), "v"(b)); return r; }

template <int MODE>
__device__ __forceinline__ void attn_unit(const Params& p, int l, int unit, LAS unsigned char* lds) {
    constexpr int NDB = MODE == 0 ? 4 : 2;
    int tid_ = threadIdx.x; asm volatile("" : "+v"(tid_));
    const int tid = tid_, wid = __builtin_amdgcn_readfirstlane(tid >> 6), lane = tid & 63, lq = lane & 31, lh = lane >> 5;
    const bf16_t* proj = (const bf16_t*)(p.ws + OFF_PROJ); bf16_t* y = (bf16_t*)(p.ws + OFF_Y);
    const int b = unit >> 6, hd = (unit >> 4) & 3, qt = unit & 15;
    const int row0 = b * SEQ + qt * 256;
    const int qrow = row0 + wid * 32 + lq;
    const int qpos = qt * 256 + wid * 32 + lq;
    int t_lo, t_hi;
    int wr_lo = 0, wr_hi = 0;
    const int gr = qt * 4 + (wid >> 1);
    const int gc = (wid & 1) * 32 + lq;
    if (MODE == 0) { t_lo = 0; t_hi = SEQ / 64; }
    else { const int r0 = qt * 4; const int a = min(max(r0 - 4, 0), 56), c = min(max(r0 + 3 - 4, 0), 56) + 8; t_lo = a; t_hi = c;
           wr_lo = min(max(gr - 4, 0), 56); wr_hi = wr_lo + 8; }
    const int kcol = MODE == 0 ? (14 * 256 + hd * 128) : (5 * 256 + hd * 64);
    const int vcol = MODE == 0 ? (16 * 256 + hd * 128) : (6 * 256 + hd * 64);
    const int qcol = MODE == 0 ? (12 * 256 + hd * 128) : (4 * 256 + hd * 64);
    unsigned ksrc, vsrc0, vsrc1 = 0;
    { const int r = tid >> 3, pos = tid & 7, ch = pos ^ ((r >> 1) & 7); ksrc = (unsigned)(r * INW + kcol + ch * 8) * 2u; }
    if (MODE == 0) {
#pragma unroll
        for (int i = 0; i < 2; ++i) { const int A = 4 * i + (tid >> 7), B = (tid >> 5) & 3, Cc = (tid >> 2) & 7, Dd = tid & 3;
            const int r = 8 * A + Cc, ch = 4 * B + (Dd ^ (2 * (A & 1) + (Cc >> 2)));
            const unsigned v = (unsigned)(r * INW + vcol + ch * 8) * 2u; if (i == 0) vsrc0 = v; else vsrc1 = v; }
    } else { const int A = wid, B = lane >> 5, Cc = (lane >> 2) & 7, Dd = lane & 3; const int r = 8 * A + Cc, ch = 4 * B + (Dd ^ (2 * (A & 1) + (Cc >> 2)));
        vsrc0 = (unsigned)(r * INW + vcol + ch * 8) * 2u; }
    const char* kvbase = (const char*)(proj + (size_t)b * SEQ * INW);
#define ATT_DMA(tile, slot) do { const char* _g = kvbase + (size_t)(tile) * 64 * INW * 2; \
        __builtin_amdgcn_global_load_lds((const unsigned*)(_g + ksrc), (LAS unsigned*)(lds + (slot) * TBUF + wid * 1024), 16, 0, 0); \
        if (MODE == 0) { __builtin_amdgcn_global_load_lds((const unsigned*)(_g + vsrc0), (LAS unsigned*)(lds + (slot) * TBUF + KBUF + wid * 1024), 16, 0, 0); \
                         __builtin_amdgcn_global_load_lds((const unsigned*)(_g + vsrc1), (LAS unsigned*)(lds + (slot) * TBUF + KBUF + 8192 + wid * 1024), 16, 0, 0); } \
        else           { __builtin_amdgcn_global_load_lds((const unsigned*)(_g + vsrc0), (LAS unsigned*)(lds + (slot) * TBUF + KBUF + wid * 2048), 16, 0, 0); } } while (0)
    unsigned kaddr[4];
#pragma unroll
    for (int kk = 0; kk < 4; ++kk) kaddr[kk] = (unsigned)(lq * 128 + 16 * ((2 * kk + lh) ^ ((lq >> 1) & 7)));
    unsigned vaddr[2];
    { const int blk = (lane >> 4) & 1, q = (lane & 15) >> 2, pp = lane & 3;
#pragma unroll
      for (int t = 0; t < 2; ++t) vaddr[t] = (unsigned)(KBUF + 64 * (4 * lh + q) + 16 * ((2 * blk + (pp >> 1)) ^ (2 * t + lh)) + 8 * (pp & 1)); }
    const float slope2 = exp2f(-2.0f * (float)(hd + 1)) * LOG2E;
    float lam = 0.f, lam_init = 0.f;
    if (MODE == 0) { const float* lp = p.diff_lambda + (size_t)l * 256;
        const float s1 = wave_sum(lp[lane] * lp[64 + lane]), s2 = wave_sum(lp[128 + lane] * lp[192 + lane]);
        lam_init = 0.8f - 0.6f * __expf(-0.3f * (float)l); lam = __expf(s1) - __expf(s2) + lam_init; }
    if (MODE == 1) {
        const float* rp = p.nat_rpb + ((size_t)l * 4 + hd) * 15 * 31; LAS float* tb = (LAS float*)(lds + RPB_OFF);
        for (int i = tid; i < 15 * 64; i += NTHREADS) { const int dr = i >> 6, c = (i & 63) - 16; tb[i] = (c >= 0 && c < 31) ? rp[dr * 31 + c] * LOG2E : 0.f; }
    }
    unsigned o1p[MODE == 0 ? 32 : 1];
    constexpr int NPASS = MODE == 0 ? 2 : 1;
#pragma unroll
    for (int pass = 0; pass < NPASS; ++pass) {
        bf16x8 qf[4];
        { const bf16_t* qp = proj + (size_t)qrow * INW + qcol + pass * 64 + 8 * lh;
#pragma unroll
          for (int kk = 0; kk < 4; ++kk) { const uint4 w = *(const uint4*)(qp + 16 * kk); const float sc = 0.125f * LOG2E;
              union { bf16x8 v; unsigned u[4]; } cv;
              cv.u[0] = pk2(lo_bf(w.x) * sc, hi_bf(w.x) * sc); cv.u[1] = pk2(lo_bf(w.y) * sc, hi_bf(w.y) * sc); cv.u[2] = pk2(lo_bf(w.z) * sc, hi_bf(w.z) * sc); cv.u[3] = pk2(lo_bf(w.w) * sc, hi_bf(w.w) * sc);
              qf[kk] = cv.v; } }
        if (MODE == 0 && pass == 1) { ksrc += 128u; }
        f32x16 o[NDB];
#pragma unroll
        for (int d = 0; d < NDB; ++d)
#pragma unroll
            for (int i = 0; i < 16; ++i) o[d][i] = 0.f;
        float m = -1e30f, lsum = 0.f;
        __syncthreads();
        ATT_DMA(t_lo, 0);
        asm volatile("s_waitcnt vmcnt(0)" ::: "memory"); __syncthreads();
        for (int t = t_lo; t < t_hi; ++t) {
            const int slot = (t - t_lo) & 1;
            if (t + 1 < t_hi) ATT_DMA(t + 1, slot ^ 1);
            const bool active = (MODE == 0) || (t >= wr_lo && t < wr_hi);
            if (active) {
                const unsigned kb_ = (unsigned)(slot * TBUF);
                f32x16 s0, s1;
#pragma unroll
                for (int i = 0; i < 16; ++i) { s0[i] = 0.f; s1[i] = 0.f; }
#pragma unroll
                for (int kk = 0; kk < 4; ++kk) {
                    const bf16x8 a0 = *(const LAS bf16x8*)(lds + kb_ + kaddr[kk]), a1 = *(const LAS bf16x8*)(lds + kb_ + kaddr[kk] + 4096);
                    s0 = __builtin_amdgcn_mfma_f32_32x32x16_bf16(a0, qf[kk], s0, 0, 0, 0);
                    s1 = __builtin_amdgcn_mfma_f32_32x32x16_bf16(a1, qf[kk], s1, 0, 0, 0);
                }
                float tmax = -3e38f;
                if (MODE == 0) {
                    const float dq = (float)(qpos - t * 64 - 4 * lh);
#pragma unroll
                    for (int i = 0; i < 16; ++i) { const float c0 = (float)((i & 3) + 8 * (i >> 2));
                        s0[i] = s0[i] - slope2 * fabsf(dq - c0); s1[i] = s1[i] - slope2 * fabsf(dq - (c0 + 32.f));
                        tmax = fmaxf(tmax, fmaxf(s0[i], s1[i])); }
                } else {
                    const LAS float* tb = (const LAS float*)(lds + RPB_OFF) + (t - gr + 7) * 64 + 16 + 15 - gc + 4 * lh;
                    const int cs = min(max(gc - 8, 0), 48) - 4 * lh;
#pragma unroll
                    for (int i = 0; i < 16; ++i) { const int c0 = (i & 3) + 8 * (i >> 2);
                        const bool v0 = (c0 >= cs) && (c0 < cs + 16), v1 = (c0 + 32 >= cs) && (c0 + 32 < cs + 16);
                        s0[i] = v0 ? s0[i] + tb[c0] : -3e38f; s1[i] = v1 ? s1[i] + tb[c0 + 32] : -3e38f;
                        tmax = fmaxf(tmax, fmaxf(s0[i], s1[i])); }
                }
                tmax = fmaxf(tmax, __shfl_xor(tmax, 32));
                const float mn = fmaxf(m, tmax);
                if (__any(mn > m)) { const float al = __builtin_amdgcn_exp2f(m - mn); lsum *= al;
#pragma unroll
                    for (int d = 0; d < NDB; ++d)
#pragma unroll
                        for (int i = 0; i < 16; ++i) o[d][i] *= al;
                    m = mn; }
                float ps = 0.f;
#pragma unroll
                for (int i = 0; i < 16; ++i) { s0[i] = __builtin_amdgcn_exp2f(s0[i] - m); s1[i] = __builtin_amdgcn_exp2f(s1[i] - m); ps += s0[i] + s1[i]; }
                lsum += ps;
                bf16x8 pf[4];
#pragma unroll
                for (int ks = 0; ks < 4; ++ks) { union { bf16x8 v; unsigned u[4]; } cv;
#pragma unroll
                    for (int j = 0; j < 4; ++j) { const int i = 8 * (ks & 1) + 2 * j; cv.u[j] = (ks < 2) ? pk2(s0[i], s0[i + 1]) : pk2(s1[i], s1[i + 1]); }
                    pf[ks] = cv.v; }
                const unsigned lbase = (unsigned)(uintptr_t)lds; const unsigned vb0 = lbase + kb_ + vaddr[0], vb1 = lbase + kb_ + vaddr[1];
#pragma unroll
                for (int ks = 0; ks < 4; ++ks) {
                    s16x4 v0[NDB], v1[NDB];
#pragma unroll
                    for (int d = 0; d < NDB; ++d) {
                        if (ks == 0) { ATT_TR(v0[d], vb0, 0 * 4096 + d * 512); ATT_TR(v1[d], vb1, 0 * 4096 + 2048 + d * 512); }
                        if (ks == 1) { ATT_TR(v0[d], vb0, 1 * 4096 + d * 512); ATT_TR(v1[d], vb1, 1 * 4096 + 2048 + d * 512); }
                        if (ks == 2) { ATT_TR(v0[d], vb0, 2 * 4096 + d * 512); ATT_TR(v1[d], vb1, 2 * 4096 + 2048 + d * 512); }
                        if (ks == 3) { ATT_TR(v0[d], vb0, 3 * 4096 + d * 512); ATT_TR(v1[d], vb1, 3 * 4096 + 2048 + d * 512); }
                    }
                    if (NDB == 4) asm volatile("s_waitcnt lgkmcnt(0)" : "+v"(v0[0]), "+v"(v1[0]), "+v"(v0[1]), "+v"(v1[1]), "+v"(v0[2]), "+v"(v1[2]), "+v"(v0[3]), "+v"(v1[3]) :: "memory");
                    else asm volatile("s_waitcnt lgkmcnt(0)" : "+v"(v0[0]), "+v"(v1[0]), "+v"(v0[1]), "+v"(v1[1]) :: "memory");
#pragma unroll
                    for (int d = 0; d < NDB; ++d) { union { bf16x8 v; s16x4 h[2]; } cv; cv.h[0] = v0[d]; cv.h[1] = v1[d];
                        o[d] = __builtin_amdgcn_mfma_f32_32x32x16_bf16(cv.v, pf[ks], o[d], 0, 0, 0); }
                }
            }
            asm volatile("s_waitcnt vmcnt(0)" ::: "memory"); __syncthreads();
        }
        const float ltot = lsum + __shfl_xor(lsum, 32), inv = 1.0f / ltot;
        if (MODE == 1) {
            bf16_t* yp = y + (size_t)qrow * 1280 + 256 + hd * 64 + 4 * lh;
#pragma unroll
            for (int d = 0; d < NDB; ++d)
#pragma unroll
                for (int g = 0; g < 4; ++g) { uint2 w; w.x = pk2(o[d][4 * g] * inv, o[d][4 * g + 1] * inv); w.y = pk2(o[d][4 * g + 2] * inv, o[d][4 * g + 3] * inv);
                    *(uint2*)(yp + 32 * d + 8 * g) = w; }
        } else if (pass == 0) {
#pragma unroll
            for (int d = 0; d < NDB; ++d)
#pragma unroll
                for (int i = 0; i < 8; ++i) o1p[(d * 8 + i) % (MODE == 0 ? 32 : 1)] = pk2(o[d][2 * i] * inv, o[d][2 * i + 1] * inv);
        } else {
            float ss = 0.f;
#pragma unroll
            for (int d = 0; d < NDB; ++d)
#pragma unroll
                for (int i = 0; i < 8; ++i) { const unsigned w = o1p[(d * 8 + i) % (MODE == 0 ? 32 : 1)];
                    const float a = lo_bf(w) - lam * o[d][2 * i] * inv, c = hi_bf(w) - lam * o[d][2 * i + 1] * inv; o[d][2 * i] = a; o[d][2 * i + 1] = c; ss += a * a + c * c; }
            ss += __shfl_xor(ss, 32);
            const float rs = rsqrtf(ss * (1.0f / 128.0f) + LN_EPS) * (1.0f - lam_init);
            const float* sl = p.diff_subln + (size_t)l * 512 + hd * 128 + 4 * lh;
            bf16_t* yp = y + (size_t)qrow * 1280 + 768 + hd * 128 + 4 * lh;
#pragma unroll
            for (int d = 0; d < NDB; ++d)
#pragma unroll
                for (int g = 0; g < 4; ++g) { const f32x4 sv = *(const f32x4*)(sl + 32 * d + 8 * g); uint2 w;
                    w.x = pk2(o[d][4 * g] * rs * sv[0], o[d][4 * g + 1] * rs * sv[1]); w.y = pk2(o[d][4 * g + 2] * rs * sv[2], o[d][4 * g + 3] * rs * sv[3]);
                    *(uint2*)(yp + 32 * d + 8 * g) = w; }
        }
    }
#undef ATT_DMA
}
#undef ATT_TR
}


namespace rec {
typedef short bf16x8 __attribute__((ext_vector_type(8)));
typedef short s16x4 __attribute__((ext_vector_type(4)));
typedef float f32x16 __attribute__((ext_vector_type(16)));
typedef float f32x4 __attribute__((ext_vector_type(4)));
#define OFF_DS    OFF_EXPW
#define OFF_SP    (OFF_EXPW + 32 * MIB)
#define OFF_ADEC  (OFF_EXPW + 64 * MIB)
#define REC_TR(dst, addr, OFF) asm volatile("ds_read_b64_tr_b16 %0, %1 offset:%2" : "=&v"(dst) : "v"(addr), "i"(OFF) : "memory")
__device__ __forceinline__ unsigned offa(unsigned row, unsigned ch) { return 2048u * (row >> 3) + 512u * (ch >> 2) + 64u * (row & 7) + 16u * ((ch & 3) ^ ((row >> 2) & 3)); }
__device__ __forceinline__ unsigned offr(unsigned row, unsigned ch) { return row * 128u + 16u * (ch ^ ((row >> 1) & 7)); }
__device__ __forceinline__ unsigned pk2(float a, float b) { unsigned r; asm volatile("v_cvt_pk_bf16_f32 %0, %1, %2" : "=v"(r) : "v"(a), "v"(b)); return r; }

struct Gates { float lf[8], kk[8], qv[8], vv[8]; };
template <bool NEED_Q>
__device__ __forceinline__ void load_gates(const Params& p, int l, int m, int dir, int b, int h, int n, int c, int seg, Gates& G) {
    const bf16_t* proj = (const bf16_t*)(p.ws + OFF_PROJ);
    const int ch = h * 64 + c; const size_t tok0 = (size_t)b * SEQ + n * 64;
    float lb = 0.f, lfc = 0.f;
    if (m == 1) { if (l == 1) { const float a0 = p.hgrn_lb[(0 * 2 + dir) * 256 + ch], a1 = p.hgrn_lb[(1 * 2 + dir) * 256 + ch]; lb = 1.0f / (1.0f + __expf(a0 - a1)); } }
    else lfc = log1pf(-exp2f(-(float)(5 + dir + 2 * h)));
#pragma unroll
    for (int e = 0; e < 8; ++e) { const int ip = 8 * seg + e; const size_t tok = tok0 + (dir ? 63 - ip : ip); const bf16_t* pr = proj + tok * INW;
        if (m == 0) { G.lf[e] = lfc; G.kk[e] = bf2f(pr[256 + ch]) * 0.125f; G.vv[e] = bf2f(pr[512 + ch]); if (NEED_Q) G.qv[e] = bf2f(pr[ch]); }
        else { const float fp = bf2f(pr[(8 + dir) * 256 + ch]); const float sg = 1.0f / (1.0f + __expf(-fp));
               G.lf[e] = __logf(lb + (1.0f - lb) * sg); G.kk[e] = (1.0f - lb) * (1.0f - sg); G.vv[e] = bf2f(pr[10 * 256 + ch]);
               if (NEED_Q) { const float qq = bf2f(pr[7 * 256 + ch]); G.qv[e] = qq / (1.0f + __expf(-qq)); } } }
}

__device__ __forceinline__ void phase_a_unit(const Params& p, int l, int u, LAS unsigned char* lds) {
    int tid_ = threadIdx.x; asm volatile("" : "+v"(tid_));
    const int tid = tid_, wid = __builtin_amdgcn_readfirstlane(tid >> 6), lane = tid & 63, c = lane, seg = wid;
    const int m = u >> 10, b = (u >> 8) & 3, h = (u >> 6) & 3, n = u & 63;
    LAS float* segsum = (LAS float*)(lds + 65536);
    Gates G[2]; float cs[2][8];
#pragma unroll
    for (int dir = 0; dir < 2; ++dir) { load_gates<false>(p, l, m, dir, b, h, n, c, seg, G[dir]);
        float a = 0.f;
#pragma unroll
        for (int e = 0; e < 8; ++e) { a += G[dir].lf[e]; cs[dir][e] = a; }
        segsum[(dir * 8 + seg) * 64 + c] = a; }
    __syncthreads();
#pragma unroll
    for (int dir = 0; dir < 2; ++dir) { float pre = 0.f, tot = 0.f;
#pragma unroll
        for (int s = 0; s < 8; ++s) { const float v = segsum[(dir * 8 + s) * 64 + c]; tot += v; pre += (s < seg) ? v : 0.f; }
        LAS unsigned char* tb = lds + dir * 16384;
#pragma unroll
        for (int e = 0; e < 8; ++e) { const int ip = 8 * seg + e; const float g = pre + cs[dir][e];
            const unsigned o = offa(ip, c >> 3) + (c & 7) * 2;
            *(LAS bf16_t*)(tb + o) = f2bf(G[dir].kk[e] * __expf(tot - g)); *(LAS bf16_t*)(tb + 1024 + o) = f2bf(G[dir].vv[e]); }
        if (seg == 0) { const int sq = ((m * 2 + dir) * 4 + b) * 4 + h; ((float*)(p.ws + OFF_ADEC))[((size_t)sq * 64 + n) * 64 + c] = __expf(tot); }
    }
    __syncthreads();
    { const int dir = wid >> 2, cb = (wid >> 1) & 1, vb = wid & 1; const unsigned lbase = (unsigned)(uintptr_t)lds + dir * 16384;
      const int lh = lane >> 5, blk = (lane >> 4) & 1, q = (lane & 15) >> 2, pp = lane & 3;
      f32x16 acc;
#pragma unroll
      for (int i = 0; i < 16; ++i) acc[i] = 0.f;
      unsigned aA[2], aB[2];
#pragma unroll
      for (int t = 0; t < 2; ++t) { const unsigned row = 8 * lh + 4 * t + q;
          aA[t] = lbase + offa(row, 4 * cb + 2 * blk + (pp >> 1)) + 8 * (pp & 1); aB[t] = lbase + 1024 + offa(row, 4 * vb + 2 * blk + (pp >> 1)) + 8 * (pp & 1); }
#pragma unroll
      for (int ks = 0; ks < 4; ++ks) { s16x4 a0, a1, b0, b1;
          if (ks == 0) { REC_TR(a0, aA[0], 0);     REC_TR(a1, aA[1], 0);     REC_TR(b0, aB[0], 0);     REC_TR(b1, aB[1], 0); }
          if (ks == 1) { REC_TR(a0, aA[0], 4096);  REC_TR(a1, aA[1], 4096);  REC_TR(b0, aB[0], 4096);  REC_TR(b1, aB[1], 4096); }
          if (ks == 2) { REC_TR(a0, aA[0], 8192);  REC_TR(a1, aA[1], 8192);  REC_TR(b0, aB[0], 8192);  REC_TR(b1, aB[1], 8192); }
          if (ks == 3) { REC_TR(a0, aA[0], 12288); REC_TR(a1, aA[1], 12288); REC_TR(b0, aB[0], 12288); REC_TR(b1, aB[1], 12288); }
          asm volatile("s_waitcnt lgkmcnt(0)" : "+v"(a0), "+v"(a1), "+v"(b0), "+v"(b1) :: "memory");
          union { bf16x8 v; s16x4 hh[2]; } ua, ub; ua.hh[0] = a0; ua.hh[1] = a1; ub.hh[0] = b0; ub.hh[1] = b1;
          acc = __builtin_amdgcn_mfma_f32_32x32x16_bf16(ua.v, ub.v, acc, 0, 0, 0); }
      const int sq = ((m * 2 + dir) * 4 + b) * 4 + h;
      bf16_t* ds = (bf16_t*)(p.ws + OFF_DS) + ((size_t)sq * 64 + n) * 4096 + 32 * vb + (lane & 31);
#pragma unroll
      for (int i = 0; i < 16; ++i) { const int cc = 32 * cb + (i & 3) + 8 * (i >> 2) + 4 * lh; ds[cc * 64] = f2bf(acc[i]); } }
    __syncthreads();
}

__device__ __forceinline__ void phase_b(const Params& p) {
    const int e2 = GTID; if (e2 >= 64 * 2048) return;
    const int sq = e2 >> 11, pr = e2 & 2047, c = pr >> 5, v2 = (pr & 31) * 2, dir = (sq >> 4) & 1;
    const unsigned* ds = (const unsigned*)(p.ws + OFF_DS) + (((size_t)sq * 64) * 4096 + c * 64 + v2) / 2;
    unsigned* sp = (unsigned*)(p.ws + OFF_SP) + (((size_t)sq * 64) * 4096 + c * 64 + v2) / 2;
    const float* ad = (const float*)(p.ws + OFF_ADEC) + (size_t)sq * 64 * 64 + c;
    float s0 = 0.f, s1 = 0.f;
    for (int n0 = 0; n0 < 64; n0 += 8) { unsigned d[8]; float a[8];
#pragma unroll
        for (int j = 0; j < 8; ++j) { const int n = dir ? 63 - (n0 + j) : n0 + j; d[j] = ds[(size_t)n * 2048]; a[j] = ad[n * 64]; }
#pragma unroll
        for (int j = 0; j < 8; ++j) { const int n = dir ? 63 - (n0 + j) : n0 + j; sp[(size_t)n * 2048] = pk2(s0, s1); s0 = a[j] * s0 + lo_bf(d[j]); s1 = a[j] * s1 + hi_bf(d[j]); } }
}

__device__ __forceinline__ void phase_c_unit(const Params& p, int l, int u, LAS unsigned char* lds) {
    int tid_ = threadIdx.x; asm volatile("" : "+v"(tid_));
    const int tid = tid_, wid = __builtin_amdgcn_readfirstlane(tid >> 6), lane = tid & 63, c = lane, seg = wid;
    const int m = u >> 10, b = (u >> 8) & 3, h = (u >> 6) & 3, n = u & 63;
    LAS float* segsum = (LAS float*)(lds + 114688);
    LAS float* outt = (LAS float*)(lds + 81920);
    {
        const int r = tid >> 3, chn = tid & 7;
#pragma unroll
        for (int dir = 0; dir < 2; ++dir) { const int sq = ((m * 2 + dir) * 4 + b) * 4 + h;
            typedef unsigned u32x4v __attribute__((ext_vector_type(4)));
            const u32x4v w = *(const u32x4v*)((const bf16_t*)(p.ws + OFF_SP) + ((size_t)sq * 64 + n) * 4096 + r * 64 + chn * 8);
            *(LAS u32x4v*)(lds + dir * 40960 + 24576 + 1024 + offa(r, chn)) = w; } }
    Gates G[2]; float cs[2][8];
#pragma unroll
    for (int dir = 0; dir < 2; ++dir) { load_gates<true>(p, l, m, dir, b, h, n, c, seg, G[dir]);
        float a = 0.f;
#pragma unroll
        for (int e = 0; e < 8; ++e) { a += G[dir].lf[e]; cs[dir][e] = a; }
        segsum[(dir * 8 + seg) * 64 + c] = a; }
    __syncthreads();
#pragma unroll
    for (int dir = 0; dir < 2; ++dir) { float pre = 0.f, gref = 0.f;
#pragma unroll
        for (int s = 0; s < 8; ++s) { const float v = segsum[(dir * 8 + s) * 64 + c]; pre += (s < seg) ? v : 0.f; gref += (s < 4) ? v : 0.f; }
        LAS unsigned char* tb = lds + dir * 40960;
#pragma unroll
        for (int e = 0; e < 8; ++e) { const int ip = 8 * seg + e; const float g = pre + cs[dir][e];
            const unsigned orow = offr(ip, c >> 3) + (c & 7) * 2, oa = offa(ip, c >> 3) + (c & 7) * 2;
            *(LAS bf16_t*)(tb + orow) = f2bf(G[dir].kk[e] * __expf(gref - g));
            *(LAS bf16_t*)(tb + 8192 + orow) = f2bf(G[dir].qv[e] * __expf(g - gref));
            *(LAS bf16_t*)(tb + 16384 + orow) = f2bf(G[dir].qv[e] * __expf(g));
            *(LAS bf16_t*)(tb + 24576 + oa) = f2bf(G[dir].vv[e]); }
    }
    __syncthreads();
    { const int dir = wid >> 2, ib = (wid >> 1) & 1, db = wid & 1; LAS unsigned char* tb = lds + dir * 40960; const unsigned lbase = (unsigned)(uintptr_t)tb;
      const int lq = lane & 31, lh = lane >> 5, blk = (lane >> 4) & 1, q = (lane & 15) >> 2, pp = lane & 3;
      f32x16 o;
#pragma unroll
      for (int i = 0; i < 16; ++i) o[i] = 0.f;
      bf16x8 qt[4], qh[4];
#pragma unroll
      for (int kk = 0; kk < 4; ++kk) { const unsigned a = offr(32 * ib + lq, 2 * kk + lh); qt[kk] = *(const LAS bf16x8*)(tb + 8192 + a); qh[kk] = *(const LAS bf16x8*)(tb + 16384 + a); }
#pragma unroll
      for (int kb = 0; kb < 2; ++kb) { if (kb <= ib) {
          f32x16 s;
#pragma unroll
          for (int i = 0; i < 16; ++i) s[i] = 0.f;
#pragma unroll
          for (int kk = 0; kk < 4; ++kk) { const bf16x8 a = *(const LAS bf16x8*)(tb + offr(32 * kb + lq, 2 * kk + lh)); s = __builtin_amdgcn_mfma_f32_32x32x16_bf16(a, qt[kk], s, 0, 0, 0); }
          const int iq = 32 * ib + lq;
#pragma unroll
          for (int i = 0; i < 16; ++i) { const int jk = 32 * kb + (i & 3) + 8 * (i >> 2) + 4 * lh; s[i] = (jk <= iq) ? s[i] : 0.f; }
#pragma unroll
          for (int sx = 0; sx < 2; ++sx) { union { bf16x8 v; unsigned uu[4]; } pf;
#pragma unroll
              for (int j = 0; j < 4; ++j) pf.uu[j] = pk2(s[8 * sx + 2 * j], s[8 * sx + 2 * j + 1]);
              s16x4 v0, v1; const unsigned ks = 2 * kb + sx;
              const unsigned a0 = lbase + 24576 + offa(16 * ks + 0 + 4 * lh + q, 4 * db + 2 * blk + (pp >> 1)) + 8 * (pp & 1);
              const unsigned a1 = lbase + 24576 + offa(16 * ks + 8 + 4 * lh + q, 4 * db + 2 * blk + (pp >> 1)) + 8 * (pp & 1);
              REC_TR(v0, a0, 0); REC_TR(v1, a1, 0);
              asm volatile("s_waitcnt lgkmcnt(0)" : "+v"(v0), "+v"(v1) :: "memory");
              union { bf16x8 v; s16x4 hh[2]; } uv; uv.hh[0] = v0; uv.hh[1] = v1;
              o = __builtin_amdgcn_mfma_f32_32x32x16_bf16(uv.v, pf.v, o, 0, 0, 0); } } }
#pragma unroll
      for (int kk = 0; kk < 4; ++kk) { s16x4 v0, v1;
          const unsigned a0 = lbase + 24576 + 1024 + offa(16 * kk + 8 * lh + 0 + q, 4 * db + 2 * blk + (pp >> 1)) + 8 * (pp & 1);
          const unsigned a1 = lbase + 24576 + 1024 + offa(16 * kk + 8 * lh + 4 + q, 4 * db + 2 * blk + (pp >> 1)) + 8 * (pp & 1);
          REC_TR(v0, a0, 0); REC_TR(v1, a1, 0);
          asm volatile("s_waitcnt lgkmcnt(0)" : "+v"(v0), "+v"(v1) :: "memory");
          union { bf16x8 v; s16x4 hh[2]; } uv; uv.hh[0] = v0; uv.hh[1] = v1;
          o = __builtin_amdgcn_mfma_f32_32x32x16_bf16(uv.v, qh[kk], o, 0, 0, 0); }
      const int ipq = 32 * ib + lq, tokl = dir ? 63 - ipq : ipq;
#pragma unroll
      for (int g = 0; g < 4; ++g) { f32x4 w; w[0] = o[4 * g]; w[1] = o[4 * g + 1]; w[2] = o[4 * g + 2]; w[3] = o[4 * g + 3];
          *(LAS f32x4*)(outt + (dir * 64 + tokl) * 64 + 32 * db + 8 * g + 4 * lh) = w; } }
    __syncthreads();
    { const int i = tid >> 3, vs = (tid & 7) * 8; const size_t tok = (size_t)b * SEQ + n * 64 + i;
      float o[8]; float ss = 0.f;
#pragma unroll
      for (int j = 0; j < 8; ++j) { o[j] = outt[i * 64 + vs + j] + outt[(64 + i) * 64 + vs + j]; ss += o[j] * o[j]; }
      ss += __shfl_xor(ss, 1); ss += __shfl_xor(ss, 2); ss += __shfl_xor(ss, 4);
      const float rs = rsqrtf(ss * (1.0f / 64.0f) + LN_EPS);
      const float* gn = (m == 0 ? p.ret_gn : p.hgrn_gn) + (size_t)l * 256 + h * 64 + vs;
      const bf16_t* gp = (const bf16_t*)(p.ws + OFF_PROJ) + tok * INW + (m == 0 ? 3 : 11) * 256 + h * 64 + vs;
      const uint4 gw = *(const uint4*)gp; const unsigned gwa[4] = {gw.x, gw.y, gw.z, gw.w}; unsigned ow[4];
#pragma unroll
      for (int j = 0; j < 4; ++j) { const float g0 = lo_bf(gwa[j]), g1 = hi_bf(gwa[j]);
          ow[j] = pk2(o[2 * j] * rs * gn[2 * j] * (g0 / (1.0f + __expf(-g0))), o[2 * j + 1] * rs * gn[2 * j + 1] * (g1 / (1.0f + __expf(-g1)))); }
      *(uint4*)((bf16_t*)(p.ws + OFF_Y) + tok * 1280 + (m == 0 ? 0 : 512) + h * 64 + vs) = make_uint4(ow[0], ow[1], ow[2], ow[3]); }
    __syncthreads();
}
#undef REC_TR
}

__device__ __forceinline__ void ph_conv_mixer_weights(const Params& p, int l, bf16_t* tile) {
    bf16_t* wtig = (bf16_t*)(p.ws + OFF_WTIG); bf16_t* wtbr = (bf16_t*)(p.ws + OFF_WTBR); bf16_t* wtout = (bf16_t*)(p.ws + OFF_WTOUT);
    const int n_in = 1152, n_gate = 1024, n_br = 64, n_bd = 128, n_out = 256;
    const int total = n_in + n_gate + 3 * n_br + n_bd + n_out;
    for (int j = blockIdx.x; j < total; j += gridDim.x) {
        int q = j;
        if (q < n_in) { const int kt = q & 15, nt = q >> 4; tconv_tile(p.w_in + (size_t)l * DM * INW, INW, kt * 64, nt * 64, wtig, DM, nt * 64, kt * 64, tile); continue; }
        q -= n_in;
        if (q < n_gate) { const int kt = q & 15, nt = q >> 4; tconv_tile(p.w_gate + (size_t)l * DM * 4096, 4096, kt * 64, nt * 64, wtig, DM, INW + nt * 64, kt * 64, tile); continue; }
        q -= n_gate;
        if (q < 3 * n_br) { const int which = q / n_br, r = q % n_br, kt = r & 3, nt = r >> 2;
            const float* src = (which == 0 ? p.w_br_ret : which == 1 ? p.w_br_nat : p.w_br_hgrn) + (size_t)l * 256 * DM;
            tconv_tile(src, DM, kt * 64, nt * 64, wtbr, 1280, nt * 64, which * 256 + kt * 64, tile); continue; }
        q -= 3 * n_br;
        if (q < n_bd) { const int kt = q & 7, nt = q >> 3; tconv_tile(p.w_br_diff + (size_t)l * 512 * DM, DM, kt * 64, nt * 64, wtbr, 1280, nt * 64, 768 + kt * 64, tile); continue; }
        q -= n_bd;
        { const int kt = q & 15, nt = q >> 4; tconv_tile(p.w_out + (size_t)l * DM * DM, DM, kt * 64, nt * 64, wtout, DM, nt * 64, kt * 64, tile); }
    }
}
__device__ __forceinline__ void ph_conv_expert_weights(const Params& p, int l, bf16_t* tile) {
    bf16_t* gu = (bf16_t*)(p.ws + OFF_EXPGU); bf16_t* dn = (bf16_t*)(p.ws + OFF_EXPDN);
    const int per_gu = 128, per_dn = 64, total = 65 * (per_gu + per_dn);
    for (int j = blockIdx.x; j < total; j += gridDim.x) {
        const int e = j / (per_gu + per_dn); int q = j % (per_gu + per_dn);
        if (q < per_gu) {
            const int kt = q & 15, nt = (q >> 4) & 1, blk = q >> 5;
            const float* src = (e < 64) ? (((blk & 1) ? p.w_e_up : p.w_e_gate) + ((size_t)l * NEXP + e) * DM * EH) : (((blk & 1) ? p.w_s_up : p.w_s_gate) + (size_t)l * DM * EH);
            tconv_tile(src, EH, kt * 64, (blk >> 1) * 128 + nt * 64, gu + (size_t)e * 512 * DM, DM, blk * 128 + nt * 64, kt * 64, tile);
        } else { q -= per_gu;
            const int kt = q & 3, nt = q >> 2;
            const float* src = (e < 64) ? (p.w_e_down + ((size_t)l * NEXP + e) * EH * DM) : (p.w_s_down + (size_t)l * EH * DM);
            tconv_tile(src, DM, kt * 64, nt * 64, dn + (size_t)e * DM * EH, EH, nt * 64, kt * 64, tile);
        }
    }
}

__device__ __forceinline__ void ph_ln_in(const Params& p) {
    bf16_t* hb = (bf16_t*)(p.ws + OFF_HB);
    const int lane = threadIdx.x & 63, gw = GTID >> 6, nw = GSIZE >> 6;
    for (int row = gw; row < NTOK; row += nw) {
        const float* xr = p.x + (size_t)row * DM;
        float4 v[4]; float s = 0.f;
#pragma unroll
        for (int i = 0; i < 4; ++i) { v[i] = *(const float4*)(xr + i * 256 + lane * 4); s += v[i].x + v[i].y + v[i].z + v[i].w; }
        const float mu = wave_sum(s) * (1.0f / DM); float q = 0.f;
#pragma unroll
        for (int i = 0; i < 4; ++i) { v[i].x -= mu; v[i].y -= mu; v[i].z -= mu; v[i].w -= mu; q += v[i].x * v[i].x + v[i].y * v[i].y + v[i].z * v[i].z + v[i].w * v[i].w; }
        const float rs = rsqrtf(wave_sum(q) * (1.0f / DM) + LN_EPS);
#pragma unroll
        for (int i = 0; i < 4; ++i) { const int c = i * 256 + lane * 4;
            const float4 g = *(const float4*)(p.ln_in_g + c), b = *(const float4*)(p.ln_in_b + c);
            ushort4 o; o.x = f2bf(v[i].x * rs * g.x + b.x); o.y = f2bf(v[i].y * rs * g.y + b.y); o.z = f2bf(v[i].z * rs * g.z + b.z); o.w = f2bf(v[i].w * rs * g.w + b.w);
            *(ushort4*)(hb + (size_t)row * DM + c) = o; }
    }
}

__device__ __forceinline__ void ph_inproj_naive(const Params& p, int l) {
    const bf16_t* hb = (const bf16_t*)(p.ws + OFF_HB); const bf16_t* wt = (const bf16_t*)(p.ws + OFF_WTIG);
    bf16_t* proj = (bf16_t*)(p.ws + OFF_PROJ); bf16_t* gates = (bf16_t*)(p.ws + OFF_GATES);
    const float* bg = p.b_gate + (size_t)l * 4096;
    const long total = (long)NTOK * 8704;
    for (long it = GTID; it < total; it += GSIZE) {
        const int col = (int)(it % 8704), row = (int)(it / 8704);
        const float acc = dot_bf16(hb + (size_t)row * DM, wt + (size_t)col * DM, DM);
        if (col < INW) proj[(size_t)row * INW + col] = f2bf(acc);
        else gates[(size_t)row * 4096 + (col - INW)] = f2bf(sigmoidf_(acc + bg[col - INW]));
    }
}

__device__ __forceinline__ void ph_recur_naive(const Params& p, int l) {
    if (blockIdx.x >= 64 || threadIdx.x >= 64) return;
    const int seq = blockIdx.x, lane = threadIdx.x;
    const int m = seq >> 5, dir = (seq >> 4) & 1, b = (seq >> 2) & 3, h = seq & 3;
    const bf16_t* proj = (const bf16_t*)(p.ws + OFF_PROJ);
    float* otmp = (float*)(p.ws + OFF_OTMP) + (size_t)(m * 2 + dir) * NTOK * 256;
    float S[64];
#pragma unroll
    for (int k = 0; k < 64; ++k) S[k] = 0.f;
    const int ch = h * 64 + lane;
    float lb = 0.f;
    if (m == 1 && l == 1) { const float a0 = p.hgrn_lb[(0 * 2 + dir) * 256 + ch], a1 = p.hgrn_lb[(1 * 2 + dir) * 256 + ch]; lb = 1.0f / (1.0f + __expf(a0 - a1)); }
    const float fret = 1.0f - exp2f(-(dir ? 6.0f : 5.0f) - 2.0f * (float)h);
    for (int s = 0; s < SEQ; ++s) {
        const int tt = dir ? (SEQ - 1 - s) : s; const size_t row = (size_t)b * SEQ + tt;
        const bf16_t* pr = proj + row * INW;
        float qv, kv, vv, fv;
        if (m == 0) { qv = bf2f(pr[ch]); kv = bf2f(pr[256 + ch]) * 0.125f; vv = bf2f(pr[512 + ch]); fv = fret; }
        else { qv = siluf_(bf2f(pr[7 * 256 + ch])); const float fp = bf2f(pr[(8 + dir) * 256 + ch]);
               fv = lb + (1.0f - lb) * sigmoidf_(fp); kv = (1.0f - lb) * sigmoidf_(-fp); vv = bf2f(pr[10 * 256 + ch]); }
        float o = 0.f;
#pragma unroll
        for (int k = 0; k < 64; ++k) {
            const float fk = __int_as_float(__builtin_amdgcn_readlane(__float_as_int(fv), k));
            const float kk = __int_as_float(__builtin_amdgcn_readlane(__float_as_int(kv), k));
            const float qk = __int_as_float(__builtin_amdgcn_readlane(__float_as_int(qv), k));
            S[k] = fk * S[k] + kk * vv; o += S[k] * qk;
        }
        otmp[row * 256 + ch] = o;
    }
}
__device__ __forceinline__ void ph_recur_finish(const Params& p, int l) {
    const bf16_t* proj = (const bf16_t*)(p.ws + OFF_PROJ); bf16_t* y = (bf16_t*)(p.ws + OFF_Y);
    const float* otmp = (const float*)(p.ws + OFF_OTMP);
    const int lane = threadIdx.x & 63, gw = GTID >> 6, nw = GSIZE >> 6;
    for (int it = gw; it < NTOK * 8; it += nw) {
        const int h = it & 3, m = (it >> 2) & 1, row = it >> 3, ch = h * 64 + lane;
        const float o = otmp[((size_t)(m * 2 + 0) * NTOK + row) * 256 + ch] + otmp[((size_t)(m * 2 + 1) * NTOK + row) * 256 + ch];
        const float ms = wave_sum(o * o) * (1.0f / 64.0f);
        const float gn = (m == 0 ? p.ret_gn : p.hgrn_gn)[(size_t)l * 256 + ch];
        const float g = bf2f(proj[(size_t)row * INW + (m == 0 ? 3 : 11) * 256 + ch]);
        y[(size_t)row * 1280 + (m == 0 ? 0 : 512) + ch] = f2bf(o * rsqrtf(ms + LN_EPS) * gn * siluf_(g));
    }
}

__device__ __forceinline__ void ph_nat_naive(const Params& p, int l) {
    const bf16_t* proj = (const bf16_t*)(p.ws + OFF_PROJ); bf16_t* y = (bf16_t*)(p.ws + OFF_Y);
    const float* rpb = p.nat_rpb + (size_t)l * 4 * 15 * 31;
    for (int it = GTID; it < NTOK * 4; it += GSIZE) {
        const int row = it % NTOK, h = it / NTOK;
        const int b = row >> 12, r = (row >> 6) & 63, c = row & 63;
        const int rs = min(max(r - 4, 0), 56), cs = min(max(c - 8, 0), 48);
        float q[64], acc[64];
        { const bf16_t* qp = proj + (size_t)row * INW + 4 * 256 + h * 64;
#pragma unroll
          for (int d = 0; d < 64; ++d) { q[d] = bf2f(qp[d]); acc[d] = 0.f; } }
        float mx = -1e30f, lsum = 0.f;
        for (int kr = 0; kr < 8; ++kr) for (int kc = 0; kc < 16; ++kc) {
            const int rr = rs + kr, cc = cs + kc; const size_t krow = (size_t)b * SEQ + rr * 64 + cc;
            const bf16_t* kp = proj + krow * INW + 5 * 256 + h * 64; const bf16_t* vp = proj + krow * INW + 6 * 256 + h * 64;
            float s = 0.f;
#pragma unroll
            for (int d = 0; d < 64; ++d) s += q[d] * bf2f(kp[d]);
            int dc = cc - c; dc = min(max(dc, -15), 15) + 15;
            s = s * 0.125f + rpb[(h * 15 + (rr - r + 7)) * 31 + dc];
            const float mn = fmaxf(mx, s), sc = __expf(mx - mn), pe = __expf(s - mn);
            lsum = lsum * sc + pe; mx = mn;
#pragma unroll
            for (int d = 0; d < 64; ++d) acc[d] = acc[d] * sc + pe * bf2f(vp[d]);
        }
        const float inv = 1.0f / lsum;
        bf16_t* yp = y + (size_t)row * 1280 + 256 + h * 64;
#pragma unroll
        for (int d = 0; d < 64; ++d) yp[d] = f2bf(acc[d] * inv);
    }
}

__device__ __forceinline__ void ph_diff_naive(const Params& p, int l) {
    const bf16_t* proj = (const bf16_t*)(p.ws + OFF_PROJ); bf16_t* dt = (bf16_t*)(p.ws + OFF_DTMP);
    for (int it = GTID; it < NTOK * 32; it += GSIZE) {
        const int row = it % NTOK, grp = it / NTOK;
        const int dvq = grp & 3, j = (grp >> 2) & 1, h = grp >> 3;
        const int b = row >> 12, qpos = row & 4095;
        const float slope = exp2f(-2.0f * (float)(h + 1));
        float q[64], acc[32];
        { const bf16_t* qp = proj + (size_t)row * INW + 12 * 256 + h * 128 + j * 64;
#pragma unroll
          for (int d = 0; d < 64; ++d) q[d] = bf2f(qp[d]) * 0.125f;
#pragma unroll
          for (int d = 0; d < 32; ++d) acc[d] = 0.f; }
        float mx = -1e30f, lsum = 0.f;
        for (int kpos = 0; kpos < SEQ; ++kpos) {
            const size_t krow = (size_t)b * SEQ + kpos;
            const bf16_t* kp = proj + krow * INW + 14 * 256 + h * 128 + j * 64; const bf16_t* vp = proj + krow * INW + 16 * 256 + h * 128 + dvq * 32;
            float s = 0.f;
#pragma unroll
            for (int d = 0; d < 64; d += 8) { const uint4 kv = *(const uint4*)(kp + d);
                s += q[d] * lo_bf(kv.x) + q[d + 1] * hi_bf(kv.x) + q[d + 2] * lo_bf(kv.y) + q[d + 3] * hi_bf(kv.y) + q[d + 4] * lo_bf(kv.z) + q[d + 5] * hi_bf(kv.z) + q[d + 6] * lo_bf(kv.w) + q[d + 7] * hi_bf(kv.w); }
            s -= slope * fabsf((float)(qpos - kpos));
            if (s > mx) { const float sc = __expf(mx - s); lsum *= sc;
#pragma unroll
                for (int d = 0; d < 32; ++d) acc[d] *= sc;
                mx = s; }
            const float pe = __expf(s - mx); lsum += pe;
#pragma unroll
            for (int d = 0; d < 32; d += 8) { const uint4 vv = *(const uint4*)(vp + d);
                acc[d] += pe * lo_bf(vv.x); acc[d + 1] += pe * hi_bf(vv.x); acc[d + 2] += pe * lo_bf(vv.y); acc[d + 3] += pe * hi_bf(vv.y);
                acc[d + 4] += pe * lo_bf(vv.z); acc[d + 5] += pe * hi_bf(vv.z); acc[d + 6] += pe * lo_bf(vv.w); acc[d + 7] += pe * hi_bf(vv.w); }
        }
        const float inv = 1.0f / lsum;
        bf16_t* op = dt + (((size_t)row * 4 + h) * 2 + j) * 128 + dvq * 32;
#pragma unroll
        for (int d = 0; d < 32; ++d) op[d] = f2bf(acc[d] * inv);
    }
}
__device__ __forceinline__ void ph_diff_finish(const Params& p, int l) {
    const bf16_t* dt = (const bf16_t*)(p.ws + OFF_DTMP); bf16_t* y = (bf16_t*)(p.ws + OFF_Y);
    const int lane = threadIdx.x & 63, gw = GTID >> 6, nw = GSIZE >> 6;
    const float* lp = p.diff_lambda + (size_t)l * 256;
    const float s1 = wave_sum(lp[lane] * lp[64 + lane]), s2 = wave_sum(lp[128 + lane] * lp[192 + lane]);
    const float lam_init = 0.8f - 0.6f * __expf(-0.3f * (float)l);
    const float lam = __expf(s1) - __expf(s2) + lam_init;
    for (int it = gw; it < NTOK * 4; it += nw) {
        const int h = it & 3, row = it >> 2;
        const bf16_t* o1 = dt + (((size_t)row * 4 + h) * 2 + 0) * 128; const bf16_t* o2 = o1 + 128;
        const float a = bf2f(o1[lane]) - lam * bf2f(o2[lane]), c = bf2f(o1[64 + lane]) - lam * bf2f(o2[64 + lane]);
        const float ms = wave_sum(a * a + c * c) * (1.0f / 128.0f), rs = rsqrtf(ms + LN_EPS) * (1.0f - lam_init);
        const float* sl = p.diff_subln + (size_t)l * 512 + h * 128;
        bf16_t* yp = y + (size_t)row * 1280 + 768 + h * 128;
        yp[lane] = f2bf(a * rs * sl[lane]); yp[64 + lane] = f2bf(c * rs * sl[64 + lane]);
    }
}

__device__ __forceinline__ void ph_merge_naive(const Params& p) {
    const bf16_t* y = (const bf16_t*)(p.ws + OFF_Y); const bf16_t* gates = (const bf16_t*)(p.ws + OFF_GATES); const bf16_t* wt = (const bf16_t*)(p.ws + OFF_WTBR);
    bf16_t* mg = (bf16_t*)(p.ws + OFF_MERGED);
    for (int it = GTID; it < NTOK * DM; it += GSIZE) {
        const int col = it & 1023, row = it >> 10;
        const bf16_t* yr = y + (size_t)row * 1280; const bf16_t* wr = wt + (size_t)col * 1280; const bf16_t* gr = gates + (size_t)row * 4096 + col;
        const float v = bf2f(gr[0]) * dot_bf16(yr, wr, 256) + bf2f(gr[1024]) * dot_bf16(yr + 256, wr + 256, 256)
                      + bf2f(gr[2048]) * dot_bf16(yr + 512, wr + 512, 256) + bf2f(gr[3072]) * dot_bf16(yr + 768, wr + 768, 512);
        mg[(size_t)row * DM + col] = f2bf(v);
    }
}
__device__ __forceinline__ void ph_outproj_naive(const Params& p) {
    const bf16_t* mg = (const bf16_t*)(p.ws + OFF_MERGED); const bf16_t* wt = (const bf16_t*)(p.ws + OFF_WTOUT); const bf16_t* hb = (const bf16_t*)(p.ws + OFF_HB);
    bf16_t* x = (bf16_t*)(p.ws + OFF_X);
    for (int it = GTID; it < NTOK * DM; it += GSIZE) {
        const int col = it & 1023, row = it >> 10;
        x[it] = f2bf(ALPHA_F * bf2f(hb[it]) + dot_bf16(mg + (size_t)row * DM, wt + (size_t)col * DM, DM));
    }
}

__device__ __forceinline__ void ph_ln1_route(const Params& p, int l, float* hrow_all) {
    const bf16_t* x = (const bf16_t*)(p.ws + OFF_X); bf16_t* hb = (bf16_t*)(p.ws + OFF_HB);
    int* tope = (int*)(p.ws + OFF_TOPE); float* topw = (float*)(p.ws + OFF_TOPW); int* topp = (int*)(p.ws + OFF_TOPP);
    unsigned* cnt = (unsigned*)(p.ws + OFF_CNT) + l * 64; int* perm = (int*)(p.ws + OFF_PERM);
    const float* g1 = p.ln1_g + (size_t)l * DM; const float* b1 = p.ln1_b + (size_t)l * DM;
    const float* wr = p.w_router + (size_t)l * DM * NEXP; const float rb = p.router_bias[l * NEXP + (threadIdx.x & 63)];
    const int lane = threadIdx.x & 63, wv = threadIdx.x >> 6, gw = GTID >> 6, nw = GSIZE >> 6;
    float* hrow = hrow_all + wv * DM;
    for (int row = gw; row < NTOK; row += nw) {
        const bf16_t* xr = x + (size_t)row * DM;
        float v[16]; float s = 0.f;
#pragma unroll
        for (int i = 0; i < 4; ++i) { const ushort4 u = *(const ushort4*)(xr + i * 256 + lane * 4); v[i * 4] = bf2f(u.x); v[i * 4 + 1] = bf2f(u.y); v[i * 4 + 2] = bf2f(u.z); v[i * 4 + 3] = bf2f(u.w);
            s += v[i * 4] + v[i * 4 + 1] + v[i * 4 + 2] + v[i * 4 + 3]; }
        const float mu = wave_sum(s) * (1.0f / DM); float q = 0.f;
#pragma unroll
        for (int i = 0; i < 16; ++i) { v[i] -= mu; q += v[i] * v[i]; }
        const float rs = rsqrtf(wave_sum(q) * (1.0f / DM) + LN_EPS);
#pragma unroll
        for (int i = 0; i < 4; ++i) { const int c = i * 256 + lane * 4;
            const float4 g = *(const float4*)(g1 + c), b = *(const float4*)(b1 + c);
            float4 o; o.x = v[i * 4] * rs * g.x + b.x; o.y = v[i * 4 + 1] * rs * g.y + b.y; o.z = v[i * 4 + 2] * rs * g.z + b.z; o.w = v[i * 4 + 3] * rs * g.w + b.w;
            *(float4*)(hrow + c) = o;
            ushort4 ob; ob.x = f2bf(o.x); ob.y = f2bf(o.y); ob.z = f2bf(o.z); ob.w = f2bf(o.w);
            *(ushort4*)(hb + (size_t)row * DM + c) = ob; }
        __builtin_amdgcn_wave_barrier();
        float lg = 0.f;
        for (int k = 0; k < DM; k += 4) { const float4 hv = *(const float4*)(hrow + k);
            lg += hv.x * wr[(size_t)k * NEXP + lane]; lg += hv.y * wr[(size_t)(k + 1) * NEXP + lane]; lg += hv.z * wr[(size_t)(k + 2) * NEXP + lane]; lg += hv.w * wr[(size_t)(k + 3) * NEXP + lane]; }
        __builtin_amdgcn_wave_barrier();
        const float score = sigmoidf_(lg), biased = score + rb;
        int rk = 0;
#pragma unroll
        for (int j = 0; j < 8; ++j) { const int src = (lane & ~7) | j; const float o = __shfl(biased, src); rk += (o > biased || (o == biased && src < lane)) ? 1 : 0; }
        float gs = (rk < 2) ? biased : 0.f;
        gs += __shfl_xor(gs, 1); gs += __shfl_xor(gs, 2); gs += __shfl_xor(gs, 4);
        int grk = 0;
#pragma unroll
        for (int j = 0; j < 8; ++j) { const float o = __shfl(gs, j * 8); const int myg = lane >> 3; grk += (o > gs || (o == gs && j < myg)) ? 1 : 0; }
        const float mval = (grk < 4) ? biased : -1e30f;
        int erk = 0;
        for (int j = 0; j < 64; ++j) { const float o = __shfl(mval, j); erk += (o > mval || (o == mval && j < lane)) ? 1 : 0; }
        const bool sel = erk < 8;
        const float wsum = wave_sum(sel ? score : 0.f);
        if (sel) {
            const float w = score / (wsum + 1e-20f) * 2.5f;
            const unsigned pos = atomicAdd(&cnt[lane], 1u);
            tope[(size_t)row * 8 + erk] = lane; topw[(size_t)row * 8 + erk] = w; topp[(size_t)row * 8 + erk] = (int)pos; perm[(size_t)lane * NTOK + pos] = row;
        }
    }
}

__device__ __forceinline__ void ph_hid_naive(const Params& p, int l, int* offs) {
    const bf16_t* hb = (const bf16_t*)(p.ws + OFF_HB); const bf16_t* gu = (const bf16_t*)(p.ws + OFF_EXPGU); bf16_t* hid = (bf16_t*)(p.ws + OFF_HID);
    const int* tope = (const int*)(p.ws + OFF_TOPE); const float* topw = (const float*)(p.ws + OFF_TOPW); const int* topp = (const int*)(p.ws + OFF_TOPP);
    const long total = (long)NTOK * 9 * EH;
    for (long it = GTID; it < total; it += GSIZE) {
        const int j = (int)(it & 255); const int slot = (int)(it >> 8); const int t = slot / 9, k = slot % 9;
        int e; float w; size_t orow;
        if (k < 8) { e = tope[t * 8 + k]; w = topw[t * 8 + k]; orow = (size_t)offs[e] + topp[t * 8 + k]; } else { e = 64; w = 1.0f; orow = (size_t)8 * NTOK + t; }
        const bf16_t* wg = gu + ((size_t)e * 512 + (j >> 7) * 256 + (j & 127)) * DM; const bf16_t* wu = wg + (size_t)128 * DM;
        const float g = dot_bf16(hb + (size_t)t * DM, wg, DM), u = dot_bf16(hb + (size_t)t * DM, wu, DM);
        (void)w; hid[orow * EH + j] = f2bf(siluf_(g) * u);
    }
}
__device__ __forceinline__ void ph_down_naive(const Params& p, int l, int* offs) {
    const bf16_t* hb = (const bf16_t*)(p.ws + OFF_HB); const bf16_t* dn = (const bf16_t*)(p.ws + OFF_EXPDN); const bf16_t* hid = (const bf16_t*)(p.ws + OFF_HID);
    bf16_t* outs = (bf16_t*)(p.ws + OFF_OUTS); bf16_t* x = (bf16_t*)(p.ws + OFF_X);
    const long total = (long)NTOK * 9 * DM;
    for (long it = GTID; it < total; it += GSIZE) {
        const int n = (int)(it & 1023); const int row = (int)(it >> 10);
        if (row < 8 * NTOK) { int e = 0;
            for (int q = 1; q < 64; ++q) e += (row >= offs[q]) ? 1 : 0;
            outs[(size_t)row * DM + n] = f2bf(dot_bf16(hid + (size_t)row * EH, dn + ((size_t)e * DM + n) * EH, EH));
        } else { const int t = row - 8 * NTOK;
            x[(size_t)t * DM + n] = f2bf(ALPHA_F * bf2f(hb[(size_t)t * DM + n]) + dot_bf16(hid + (size_t)row * EH, dn + ((size_t)64 * DM + n) * EH, EH)); }
    }
}
__device__ __forceinline__ void ph_combine_ln2(const Params& p, int l, int* offs) {
    const bf16_t* x = (const bf16_t*)(p.ws + OFF_X); const bf16_t* outs = (const bf16_t*)(p.ws + OFF_OUTS); bf16_t* hb = (bf16_t*)(p.ws + OFF_HB);
    const int* tope = (const int*)(p.ws + OFF_TOPE); const int* topp = (const int*)(p.ws + OFF_TOPP); const float* topw = (const float*)(p.ws + OFF_TOPW);
    const float* g2 = p.ln2_g + (size_t)l * DM; const float* b2 = p.ln2_b + (size_t)l * DM;
    const int lane = threadIdx.x & 63, gw = GTID >> 6, nw = GSIZE >> 6;
    for (int row = gw; row < NTOK; row += nw) {
        float v[16];
#pragma unroll
        for (int i = 0; i < 4; ++i) { const ushort4 u = *(const ushort4*)(x + (size_t)row * DM + i * 256 + lane * 4); v[i * 4] = bf2f(u.x); v[i * 4 + 1] = bf2f(u.y); v[i * 4 + 2] = bf2f(u.z); v[i * 4 + 3] = bf2f(u.w); }
        for (int k = 0; k < 8; ++k) { const size_t r = (size_t)offs[tope[row * 8 + k]] + topp[row * 8 + k]; const float w = topw[row * 8 + k];
#pragma unroll
            for (int i = 0; i < 4; ++i) { const ushort4 u = *(const ushort4*)(outs + r * DM + i * 256 + lane * 4); v[i * 4] += w * bf2f(u.x); v[i * 4 + 1] += w * bf2f(u.y); v[i * 4 + 2] += w * bf2f(u.z); v[i * 4 + 3] += w * bf2f(u.w); } }
        float s = 0.f;
#pragma unroll
        for (int i = 0; i < 16; ++i) s += v[i];
        const float mu = wave_sum(s) * (1.0f / DM); float q = 0.f;
#pragma unroll
        for (int i = 0; i < 16; ++i) { v[i] -= mu; q += v[i] * v[i]; }
        const float rs = rsqrtf(wave_sum(q) * (1.0f / DM) + LN_EPS);
#pragma unroll
        for (int i = 0; i < 4; ++i) { const int c = i * 256 + lane * 4;
            const float4 g = *(const float4*)(g2 + c), b = *(const float4*)(b2 + c);
            float4 o; o.x = v[i * 4] * rs * g.x + b.x; o.y = v[i * 4 + 1] * rs * g.y + b.y; o.z = v[i * 4 + 2] * rs * g.z + b.z; o.w = v[i * 4 + 3] * rs * g.w + b.w;
            if (l == NLAYER - 1) *(float4*)(p.out + (size_t)row * DM + c) = o;
            else { ushort4 ob; ob.x = f2bf(o.x); ob.y = f2bf(o.y); ob.z = f2bf(o.z); ob.w = f2bf(o.w); *(ushort4*)(hb + (size_t)row * DM + c) = ob; } }
    }
}

__device__ __forceinline__ void ph_inproj_fast(const Params& p, int l, LAS unsigned char* stage) {
    g8::StaticSched S; S.init(p.ws + OFF_HB, DM, p.ws + OFF_WTIG, DM, NTOK, 8704, DM, (int)gridDim.x, (int)blockIdx.x);
    g8::EpiInGate E{(bf16_t*)(p.ws + OFF_PROJ), (bf16_t*)(p.ws + OFF_GATES), p.b_gate + (size_t)l * 4096};
    g8::gemm_stream(stage, S, E);
}
__device__ __forceinline__ void ph_merge_fast(const Params& p, LAS unsigned char* stage) {
    g8::StaticSched S; g8::EpiMerge E{(bf16_t*)(p.ws + OFF_MERGED), (const bf16_t*)(p.ws + OFF_GATES), 0};
    S.init(p.ws + OFF_Y, 1280, p.ws + OFF_WTBR, 1280, NTOK, DM, 256, (int)gridDim.x, (int)blockIdx.x); E.b = 0; g8::gemm_stream(stage, S, E);
    asm volatile("s_waitcnt vmcnt(0)" ::: "memory"); __syncthreads();
    S.init(p.ws + OFF_Y + 512, 1280, p.ws + OFF_WTBR + 512, 1280, NTOK, DM, 256, (int)gridDim.x, (int)blockIdx.x); E.b = 1; g8::gemm_stream(stage, S, E);
    asm volatile("s_waitcnt vmcnt(0)" ::: "memory"); __syncthreads();
    S.init(p.ws + OFF_Y + 1024, 1280, p.ws + OFF_WTBR + 1024, 1280, NTOK, DM, 256, (int)gridDim.x, (int)blockIdx.x); E.b = 2; g8::gemm_stream(stage, S, E);
    asm volatile("s_waitcnt vmcnt(0)" ::: "memory"); __syncthreads();
    S.init(p.ws + OFF_Y + 1536, 1280, p.ws + OFF_WTBR + 1536, 1280, NTOK, DM, 512, (int)gridDim.x, (int)blockIdx.x); E.b = 3; g8::gemm_stream(stage, S, E);
}
__device__ __forceinline__ void ph_outproj_fast(const Params& p, LAS unsigned char* stage) {
    g8::StaticSched S; S.init(p.ws + OFF_MERGED, DM, p.ws + OFF_WTOUT, DM, NTOK, DM, DM, (int)gridDim.x, (int)blockIdx.x);
    g8::EpiResid E{(bf16_t*)(p.ws + OFF_X), (const bf16_t*)(p.ws + OFF_HB)};
    g8::gemm_stream(stage, S, E);
}
__device__ __forceinline__ void ph_hid_fast(const Params& p, const LAS int* offs, const LAS int* tp, LAS unsigned char* stage) {
    g8::GroupSched<true> S; S.A = (const char*)(p.ws + OFF_HB); S.B = (const char*)(p.ws + OFF_EXPGU); S.bstride = (size_t)512 * DM * 2; S.lda = DM; S.ldb = DM; S.K = DM;
    S.offs = offs; S.tp = tp; S.perm = (const int*)(p.ws + OFF_PERM); S.NC = 2; S.G = (int)gridDim.x; S.c = (int)blockIdx.x;
    g8::EpiGateUp E{(bf16_t*)(p.ws + OFF_HID)};
    g8::gemm_stream(stage, S, E);
}
__device__ __forceinline__ void ph_down_fast(const Params& p, const LAS int* offs, const LAS int* tp, LAS unsigned char* stage) {
    g8::GroupSched<false> S; S.A = (const char*)(p.ws + OFF_HID); S.B = (const char*)(p.ws + OFF_EXPDN); S.bstride = (size_t)DM * EH * 2; S.lda = EH; S.ldb = EH; S.K = EH;
    S.offs = offs; S.tp = tp; S.perm = nullptr; S.NC = 4; S.G = (int)gridDim.x; S.c = (int)blockIdx.x;
    g8::EpiDown E{(bf16_t*)(p.ws + OFF_OUTS), (bf16_t*)(p.ws + OFF_X), (const bf16_t*)(p.ws + OFF_HB)};
    g8::gemm_stream(stage, S, E);
}

__device__ __forceinline__ void ph_attn_fast(const Params& p, int l, LAS unsigned char* stage) {
    if (FAST_MASK & 32) { for (int u = blockIdx.x; u < 256; u += gridDim.x) att::attn_unit<1>(p, l, u, stage); } else ph_nat_naive(p, l);
    if (FAST_MASK & 64) { for (int u = blockIdx.x; u < 256; u += gridDim.x) att::attn_unit<0>(p, l, u, stage); } else ph_diff_naive(p, l);
}

#define NPH 16
#define STAGE_OFF 1024
__global__ void __launch_bounds__(NTHREADS, 2) fwd_kernel(Params p) {
    extern __shared__ __attribute__((aligned(16))) unsigned char lds[];
    LAS unsigned char* ldsl = (LAS unsigned char*)lds;
    volatile LAS unsigned* xbw = (volatile LAS unsigned*)ldsl;
    LAS int* offs = (LAS int*)(ldsl + 16);
    LAS int* tp = (LAS int*)(ldsl + 512);
    LAS unsigned char* stage = ldsl + STAGE_OFF;
    unsigned char* scratch = lds + STAGE_OFF;
    if (threadIdx.x < 4) xbw[threadIdx.x] = 0u;
    __syncthreads();
    XcdBarrier bar = xcd_barrier_post((unsigned*)(p.ws + OFF_BAR), xbw);
    const int lo = p.ph_lo, hi = p.ph_hi;
#define IN(k) (lo <= (k) && (k) < hi)
#define SEAM(k) do { if (IN(k) && IN((k) + 1)) xcd_barrier(bar); } while (0)
#define LAYER_BODY(l) do { \
        const int pb = l * NPH; \
        if (IN(pb + 0)) { ph_conv_mixer_weights(p, l, (bf16_t*)scratch); if (l == 0) ph_ln_in(p); } \
        SEAM(pb + 0); \
        if (IN(pb + 1)) { if (FAST_MASK & 1) ph_inproj_fast(p, l, stage); else ph_inproj_naive(p, l); } \
        SEAM(pb + 1); \
        if (IN(pb + 2)) { if (FAST_MASK & 128) { for (int u = blockIdx.x; u < 2048; u += gridDim.x) rec::phase_a_unit(p, l, u, stage); } else ph_recur_naive(p, l); } \
        SEAM(pb + 2); \
        if (IN(pb + 10)) { if (FAST_MASK & 128) rec::phase_b(p); ph_attn_fast(p, l, stage); } \
        if (IN(pb + 10) && IN(pb + 3)) xcd_barrier(bar); \
        if (IN(pb + 3)) { if (FAST_MASK & 128) { for (int u = blockIdx.x; u < 2048; u += gridDim.x) rec::phase_c_unit(p, l, u, stage); } else ph_recur_finish(p, l); if (!(FAST_MASK & 64)) ph_diff_finish(p, l); } \
        SEAM(pb + 3); \
        if (IN(pb + 4)) { if (FAST_MASK & 2) ph_merge_fast(p, stage); else ph_merge_naive(p); } \
        SEAM(pb + 4); \
        if (IN(pb + 5)) { if (FAST_MASK & 4) ph_outproj_fast(p, stage); else ph_outproj_naive(p); __syncthreads(); ph_conv_expert_weights(p, l, (bf16_t*)scratch); } \
        SEAM(pb + 5); \
        if (IN(pb + 6)) ph_ln1_route(p, l, (float*)scratch); \
        SEAM(pb + 6); \
        if (IN(pb + 7) || IN(pb + 8) || IN(pb + 9)) {    \
            __syncthreads(); \
            if (threadIdx.x == 0) { const unsigned* cnt = (const unsigned*)(p.ws + OFF_CNT) + l * 64; int a = 0, t = 0; \
                for (int e = 0; e < 64; ++e) { offs[e] = a; tp[e] = t; const int c = (int)cnt[e]; a += c; t += (c + 255) >> 8; } \
                offs[64] = a; tp[64] = t; offs[65] = a + NTOK; tp[65] = t + NTOK / 256; } \
            __syncthreads(); \
        } \
        if (IN(pb + 7)) { if (FAST_MASK & 8) ph_hid_fast(p, offs, tp, stage); else ph_hid_naive(p, l, (int*)(lds + 16)); } \
        SEAM(pb + 7); \
        if (IN(pb + 8)) { if (FAST_MASK & 16) ph_down_fast(p, offs, tp, stage); else ph_down_naive(p, l, (int*)(lds + 16)); } \
        SEAM(pb + 8); \
        if (IN(pb + 9)) ph_combine_ln2(p, l, (int*)(lds + 16)); \
        SEAM(pb + 9); \
    } while (0)
    LAYER_BODY(0);
    LAYER_BODY(1);
#undef IN
#undef SEAM
}

#define LDS_BYTES (STAGE_OFF + 128 * 1024)

extern "C" void kernel_launch(void* const* d_in, const int* in_sizes, int n_in, void* d_out, int out_size, void* d_ws, size_t ws_size, hipStream_t stream) {
    static int grid = 0;
    if (grid == 0) {
        if (n_in != 29 || out_size != NTOK * DM || ws_size < WS_END) { fprintf(stderr, "kernel_launch: unexpected shapes (n_in %d out %d ws %zu need %zu)\n", n_in, out_size, ws_size, (size_t)WS_END); grid = -1; return; }
        int dev = 0, cus = 0, per_cu = 0;
        if (hipGetDevice(&dev) != hipSuccess || hipDeviceGetAttribute(&cus, hipDeviceAttributeMultiprocessorCount, dev) != hipSuccess) { grid = -1; return; }
        if (hipFuncSetAttribute((const void*)fwd_kernel, hipFuncAttributeMaxDynamicSharedMemorySize, LDS_BYTES) != hipSuccess) { grid = -1; return; }
        if (hipOccupancyMaxActiveBlocksPerMultiprocessor(&per_cu, (const void*)fwd_kernel, NTHREADS, LDS_BYTES) != hipSuccess || per_cu < 1) { fprintf(stderr, "occupancy query: %d\n", per_cu); }
        (void)hipGetLastError();
        grid = cus;
    }
    if (grid < 0) return;
    hipMemsetAsync((char*)d_ws, 0, CTL_ZERO_BYTES, stream);
    Params p{};
    const float** pp = (const float**)&p;
    for (int i = 0; i < 29; ++i) pp[i] = (const float*)d_in[i];
    p.out = (float*)d_out; p.ws = (unsigned char*)d_ws; p.ph_lo = 0; p.ph_hi = NLAYER * NPH;
    hipLaunchKernelGGL(fwd_kernel, dim3(grid), dim3(NTHREADS), LDS_BYTES, stream, p);
}

#ifdef TEST_PHASE
__global__ void __launch_bounds__(NTHREADS, 2) test_kernel(Params p) {
    extern __shared__ __attribute__((aligned(16))) unsigned char lds[];
    LAS unsigned char* ldsl = (LAS unsigned char*)lds;
    LAS int* offs = (LAS int*)(ldsl + 16); LAS int* tp = (LAS int*)(ldsl + 512);
    LAS unsigned char* stage = ldsl + STAGE_OFF;
#if TEST_PHASE == 1
    ph_inproj_fast(p, 1, stage);
#elif TEST_PHASE == 2
    ph_merge_fast(p, stage);
#elif TEST_PHASE == 3
    ph_outproj_fast(p, stage);
#elif TEST_PHASE == 4
    ph_hid_fast(p, offs, tp, stage);
#elif TEST_PHASE == 5
    ph_down_fast(p, offs, tp, stage);
#endif
}
#endif
```

```cpp
#include <hip/hip_runtime.h>
#include <stdint.h>
#include <stdio.h>
#ifndef REPEAT_PH
#define REPEAT_PH -1
#endif
#ifndef FAST_MASK
#define FAST_MASK 0x1ff
#endif

typedef unsigned short bf16_t;
typedef unsigned int u32;

#define NTOK 16384
#define SEQ 4096
#define DM 1024
#define INW 4608
#define NLAYER 2
#define NEXP 64
#define EH 256
#define ALPHA_F 1.41421356237309515f
#define LN_EPS 1e-5f
#define NTHREADS 512

#define MIB ((size_t)1 << 20)
#define OFF_BAR   ((size_t)0)
#define OFF_CNT   ((size_t)16384)
#define CTL_ZERO_BYTES ((size_t)32768)
#define OFF_WTIG  (1 * MIB)
#define OFF_WTBR  (18 * MIB)
#define OFF_WTOUT (OFF_WTBR + 2560 * 1024)
#define OFF_HB    (23 * MIB)
#define OFF_X     (55 * MIB)
#define OFF_EXPW  (87 * MIB)
#define OFF_EXPGU OFF_EXPW
#define OFF_EXPDN (OFF_EXPW + 65 * MIB)
#define OFF_OTMP  OFF_EXPW
#define OFF_ROUTE (185 * MIB)
#define OFF_TOPE  OFF_ROUTE
#define OFF_TOPW  (OFF_ROUTE + 512 * 1024)
#define OFF_TOPP  (OFF_ROUTE + 1024 * 1024)
#define OFF_PERM  (OFF_ROUTE + 1536 * 1024)
#define OFF_R     (191 * MIB)
#define OFF_PROJ  OFF_R
#define OFF_GATES (OFF_R + 144 * MIB)
#define OFF_Y     (OFF_R + 272 * MIB)
#define OFF_MERGED OFF_R
#define OFF_HID   OFF_R
#define OFF_OUTS  (OFF_R + 72 * MIB)
#define OFF_DTMP  OFF_X
#define WS_END    (OFF_R + 328 * MIB)

struct Params {
    const float* x; const float* ln_in_g; const float* ln_in_b; const float* w_in; const float* w_gate; const float* b_gate;
    const float* w_br_ret; const float* w_br_nat; const float* w_br_hgrn; const float* w_br_diff; const float* w_out;
    const float* ret_gn; const float* nat_rpb; const float* hgrn_lb; const float* hgrn_gn; const float* diff_lambda; const float* diff_subln;
    const float* ln1_g; const float* ln1_b; const float* w_router; const float* router_bias;
    const float* w_e_gate; const float* w_e_up; const float* w_e_down; const float* w_s_gate; const float* w_s_up; const float* w_s_down;
    const float* ln2_g; const float* ln2_b;
    float* out; unsigned char* ws;
    int ph_lo, ph_hi;
};


#define WIDTAB_OFF 1024
#ifndef LAS
#define LAS __attribute__((address_space(3)))
#endif
__device__ __forceinline__ int tidx_() {
    extern __shared__ __attribute__((aligned(16))) unsigned char lds_any_[];
    const unsigned hw = (unsigned)__builtin_amdgcn_s_getreg((5 << 11) | 4) & 63u;
    const int wid = ((volatile LAS int*)((LAS unsigned char*)lds_any_ + WIDTAB_OFF))[hw];
    int lane; asm volatile("v_mbcnt_lo_u32_b32 %0, -1, 0\n\tv_mbcnt_hi_u32_b32 %0, -1, %0" : "=v"(lane));
    return __builtin_amdgcn_readfirstlane(wid) * 64 + lane;
}
#define TIDX tidx_()

#define XB_TMO      128
#define XB_XCNT(j)  (256  + 64 * (j))
#define XB_XSUB(j)  (1280 + 64 * (j))
#define XB_XGEN(j)  (2304 + 64 * (j))
#define XB_TOP      3328
#define XB_TOPGEN   3392
#define XCD_BAR_WORDS 3456
#define XB_SPIN_CAP (1u << 27)
#define LAS __attribute__((address_space(3)))

__device__ __forceinline__ unsigned xb_ld(unsigned* p)              { return __hip_atomic_load(p, __ATOMIC_RELAXED, __HIP_MEMORY_SCOPE_AGENT); }
__device__ __forceinline__ unsigned xb_add(unsigned* p, unsigned v) { return __hip_atomic_fetch_add(p, v, __ATOMIC_RELAXED, __HIP_MEMORY_SCOPE_AGENT); }
__device__ __forceinline__ unsigned xb_xcc_id() { return (unsigned)__builtin_amdgcn_s_getreg((3 << 11) | 20) & 0xFu; }
#define XB_SPIN(cond, bar) do { unsigned _sp = 0; while (cond) { __builtin_amdgcn_s_sleep(1); \
    if ((++_sp & 255u) == 0u) { if (xb_ld(&(bar)[XB_TMO])) break; if (_sp > XB_SPIN_CAP) { atomicAdd(&(bar)[XB_TMO], 1u); break; } } } } while (0)

struct XcdBarrier { unsigned* bar; unsigned x; volatile LAS unsigned* st; };

__device__ __forceinline__ XcdBarrier xcd_barrier_post(unsigned* bar, volatile LAS unsigned* st) {
    XcdBarrier b; b.bar = bar; b.x = xb_xcc_id(); b.st = st;
    if (TIDX == 0) (void)xb_add(&bar[XB_XCNT(b.x)], 1u);
    return b;
}
__device__ __forceinline__ void xcd_barrier_complete(unsigned* bar, unsigned x, unsigned& nloc, unsigned& nx) {
    const unsigned G = gridDim.x * gridDim.y * gridDim.z;
    unsigned sum, cnt, mine, sp = 0u;
    for (;;) {
        sum = 0u; cnt = 0u; mine = 0u;
#pragma unroll
        for (unsigned j = 0; j < 16; ++j) { const unsigned c = xb_ld(&bar[XB_XCNT(j)]); sum += c; cnt += (c > 0u) ? 1u : 0u; mine = (j == x) ? c : mine; }
        if (sum == G) break;
        __builtin_amdgcn_s_sleep(1);
        if ((++sp & 255u) == 0u) { if (xb_ld(&bar[XB_TMO])) break; if (sp > XB_SPIN_CAP) { atomicAdd(&bar[XB_TMO], 1u); break; } }
    }
    nloc = mine > 0u ? mine : 1u; nx = cnt > 0u ? cnt : 1u;
}
__device__ __forceinline__ void xcd_barrier(const XcdBarrier& b) {
    asm volatile("s_waitcnt vmcnt(0)" ::: "memory");
    __syncthreads();
    if (TIDX == 0) {
        unsigned* bar = b.bar;
        __builtin_amdgcn_s_waitcnt(0);
        unsigned nloc = b.st[0], nx = b.st[1];
        if (nloc == 0u) { xcd_barrier_complete(bar, b.x, nloc, nx); b.st[0] = nloc; b.st[1] = nx; }
        const unsigned old = xb_add(&bar[XB_XSUB(b.x)], 1u);
        const unsigned gen = old / nloc;
        if (old + 1u == (gen + 1u) * nloc) {
            __builtin_amdgcn_fence(__ATOMIC_RELEASE, "agent");
            asm volatile("s_waitcnt vmcnt(0)" ::: "memory");
            const unsigned og = xb_add(&bar[XB_TOP], 1u);
            const unsigned tg = og / nx;
            if (og + 1u == (tg + 1u) * nx) xb_add(&bar[XB_TOPGEN], 1u);
            else XB_SPIN(xb_ld(&bar[XB_TOPGEN]) == tg, bar);
            __builtin_amdgcn_fence(__ATOMIC_ACQUIRE, "agent");
            xb_add(&bar[XB_XGEN(b.x)], 1u);
            asm volatile("s_waitcnt vmcnt(0)" ::: "memory");
        } else {
            XB_SPIN(xb_ld(&bar[XB_XGEN(b.x)]) == gen, bar);
            __builtin_amdgcn_fence(__ATOMIC_ACQUIRE, "agent");
            asm volatile("s_waitcnt vmcnt(0)" ::: "memory");
        }
    }
    __syncthreads();
}

__device__ __forceinline__ float bf2f(bf16_t b) { return __uint_as_float(((unsigned)b) << 16); }
__device__ __forceinline__ bf16_t f2bf(float f) { unsigned u = __float_as_uint(f); u += 0x7FFFu + ((u >> 16) & 1u); return (bf16_t)(u >> 16); }
__device__ __forceinline__ float lo_bf(unsigned w) { return __uint_as_float(w << 16); }
__device__ __forceinline__ float hi_bf(unsigned w) { return __uint_as_float(w & 0xFFFF0000u); }
__device__ __forceinline__ float sigmoidf_(float v) { return 1.0f / (1.0f + __expf(-v)); }
__device__ __forceinline__ float siluf_(float v) { return v / (1.0f + __expf(-v)); }
__device__ __forceinline__ float wave_sum(float v) {
#pragma unroll
    for (int o = 32; o > 0; o >>= 1) v += __shfl_xor(v, o);
    return v;
}
__device__ __forceinline__ float dot_bf16(const bf16_t* a, const bf16_t* b, int K) {
    float s = 0.f;
    for (int k = 0; k < K; k += 8) {
        const uint4 va = *(const uint4*)(a + k), vb = *(const uint4*)(b + k);
        s += lo_bf(va.x) * lo_bf(vb.x) + hi_bf(va.x) * hi_bf(vb.x) + lo_bf(va.y) * lo_bf(vb.y) + hi_bf(va.y) * hi_bf(vb.y)
           + lo_bf(va.z) * lo_bf(vb.z) + hi_bf(va.z) * hi_bf(vb.z) + lo_bf(va.w) * lo_bf(vb.w) + hi_bf(va.w) * hi_bf(vb.w);
    }
    return s;
}

#define GTID ((int)(blockIdx.x * NTHREADS + TIDX))
#define GSIZE ((int)(gridDim.x * NTHREADS))

__device__ __forceinline__ void tconv_tile(const float* src, int lds_, int sk0, int sc0, bf16_t* dst, int ldd, int dn0, int dk0, bf16_t* tile) {
    const int t = TIDX;
#pragma unroll
    for (int i = 0; i < 2; ++i) {
        const int row = (t >> 4) + 32 * i, c4 = (t & 15) * 4;
        const float4 v = *(const float4*)(src + (size_t)(sk0 + row) * lds_ + sc0 + c4);
        tile[(c4 + 0) * 72 + row] = f2bf(v.x); tile[(c4 + 1) * 72 + row] = f2bf(v.y); tile[(c4 + 2) * 72 + row] = f2bf(v.z); tile[(c4 + 3) * 72 + row] = f2bf(v.w);
    }
    __syncthreads();
    { const int n = t >> 3, ch = t & 7;
      const uint4 w = *(const uint4*)&tile[n * 72 + ch * 8];
      *(uint4*)(dst + (size_t)(dn0 + n) * ldd + dk0 + ch * 8) = w; }
    __syncthreads();
}


namespace g8 {
typedef short bf16x8 __attribute__((ext_vector_type(8)));
typedef float f32x4 __attribute__((ext_vector_type(4)));
typedef unsigned u32x4 __attribute__((ext_vector_type(4)));
constexpr int BM = 256, BK = 64, HALF = 128, HTB = HALF * BK * 2, STAGE_BYTES = 8 * HTB, NXCD = 8, WGM = 8;
__device__ __forceinline__ int lds_byte(int r, int c) { const int st = (r >> 4) * 2 + (c >> 5), rr = r & 15, cc = c & 31, ob = rr * 64 + cc * 2; return st * 1024 + (ob ^ (((ob >> 9) & 1) << 5)); }
__device__ __forceinline__ void stage_rc(int b, int& R, int& C) { const int st = b / 1024, sb = b % 1024, swz = sb ^ (((sb >> 9) & 1) << 5); R = (st >> 1) * 16 + swz / 64; C = (st & 1) * 32 + (swz % 64) / 2; }
__device__ __forceinline__ int perm32(int rho) { const int n = rho >> 4, i = rho & 15; return 8 * (i >> 2) + 4 * n + (i & 3); }
__device__ __forceinline__ unsigned cvt_pk_bf16(float lo, float hi) { unsigned r; asm volatile("v_cvt_pk_bf16_f32 %0, %1, %2" : "=v"(r) : "v"(lo), "v"(hi)); return r; }

struct Unit { const char* A; const char* B; int row0, col0, nvalid, e, loc0, nt; };

struct StaticSched {
    static constexpr bool GATHER = false;
    const char* A; const char* B; int lda, ldb, K; int nM, nN, nwg, G, c;
    __device__ void init(const void* A_, int lda_, const void* B_, int ldb_, int M, int N, int K_, int G_, int c_) { A = (const char*)A_; B = (const char*)B_; lda = lda_; ldb = ldb_; K = K_; nM = M / BM; nN = N / BM; nwg = nM * nN; G = G_; c = c_; }
    __device__ __forceinline__ bool next(int i, Unit& u) const {
        const long L = (long)i * G + c; if (L >= nwg) return false;
        int wgid = (int)L; { const int q = nwg / NXCD, r = nwg % NXCD, xcd = wgid % NXCD, off = wgid / NXCD; wgid = (xcd < r ? xcd * (q + 1) : r * (q + 1) + (xcd - r) * q) + off; }
        const int nig = WGM * nN, gid = wgid / nig, fm = gid * WGM, gsz = (nM - fm) < WGM ? (nM - fm) : WGM;
        const int pm = fm + ((wgid % nig) % gsz), pn = (wgid % nig) / gsz;
        u.row0 = pm * BM; u.col0 = pn * BM; u.nvalid = BM; u.e = 0; u.loc0 = 0; u.nt = K / BK;
        u.A = A + (size_t)u.row0 * lda * 2; u.B = B + (size_t)u.col0 * ldb * 2; return true;
    }
    __device__ __forceinline__ void gather(const Unit&, int, int, unsigned&, unsigned&) const {}
};

struct MergeSched {
    static constexpr bool GATHER = false;
    const char* A; const char* B; int lda, ldb, K; int G, c;
    __device__ __forceinline__ bool next(int i, Unit& u) const {
        const int tile = c + (i >> 2) * G, b = i & 3; if (tile >= 256) return false;
        int wgid = tile; { const int xcd = wgid % NXCD, off = wgid / NXCD; wgid = xcd * 32 + off; }
        const int nN = 4, nig = WGM * nN, gid = wgid / nig, fm = gid * WGM;
        const int pm = fm + ((wgid % nig) % WGM), pn = (wgid % nig) / WGM;
        u.row0 = pm * BM; u.col0 = pn * BM; u.nvalid = BM; u.e = b; u.loc0 = 0; u.nt = (b == 3) ? 8 : 4;
        u.A = A + (size_t)u.row0 * lda * 2 + b * 512; u.B = B + (size_t)u.col0 * ldb * 2 + b * 512; return true;
    }
    __device__ __forceinline__ void gather(const Unit&, int, int, unsigned&, unsigned&) const {}
};
template <bool GATHER_> struct GroupSched {
    static constexpr bool GATHER = GATHER_;
    const char* A; const char* B; size_t bstride; int lda, ldb, K; const LAS int* offs; const LAS int* tp; const int* perm; int NC, G, c;
    __device__ __forceinline__ bool next(int i, Unit& u) const {
        const int L = i * G + c; const int total = tp[65] * NC; if (L >= total) return false;
        const int tl = L / NC, ct = L - tl * NC; const int lane = TIDX & 63;
        int e = (int)__builtin_popcountll(__ballot(tp[lane] <= tl)) - 1; if (tl >= tp[64]) e = 64;
        e = __builtin_amdgcn_readfirstlane(e);
        const int rt = tl - tp[e], cnt = offs[e + 1] - offs[e];
        u.e = e; u.nt = K / BK; u.loc0 = rt * BM; u.row0 = offs[e] + rt * BM; u.nvalid = (cnt - rt * BM) < BM ? (cnt - rt * BM) : BM; u.col0 = ct * BM;
        u.B = B + (size_t)e * bstride + (size_t)u.col0 * ldb * 2;
        u.A = GATHER ? A : A + (size_t)u.row0 * lda * 2; return true;
    }
    __device__ __forceinline__ void gather(const Unit& u, int R, int C, unsigned& o0, unsigned& o1) const {
        const int r0 = R < u.nvalid ? R : 0, r1 = (128 + R) < u.nvalid ? (128 + R) : 0;
        const int p0 = u.loc0 + r0, p1 = u.loc0 + r1;
        const int t0 = (u.e < 64) ? perm[u.e * NTOK + p0] : p0, t1 = (u.e < 64) ? perm[u.e * NTOK + p1] : p1;
        o0 = (unsigned)(t0 * lda + C) * 2u; o1 = (unsigned)(t1 * lda + C) * 2u;
    }
};

template <class Epi, class Sched>
__device__ __forceinline__ void gemm_stream(LAS unsigned char* lds, const Sched& S, const Epi& E) {
    int tid_ = TIDX; asm volatile("" : "+v"(tid_));
    const int tid = tid_, wid = __builtin_amdgcn_readfirstlane(tid >> 6), lane = tid & 63, wr = wid >> 2, wc = wid & 3, fr = lane & 15, fq = lane >> 4;
    const int lda = S.lda, ldb = S.ldb;
    unsigned voffA0[2], voffA1[2], voffB[2]; int RR[2], CC[2];
#pragma unroll
    for (int i = 0; i < 2; ++i) { int R, C; stage_rc(tid * 16 + i * 8192, R, C); const int Rb = Epi::PERM ? ((R & ~31) + perm32(R & 31)) : R; RR[i] = R; CC[i] = C;
        voffA0[i] = (unsigned)(R * lda + C) * 2u; voffA1[i] = voffA0[i] + (unsigned)(HALF * lda) * 2u; voffB[i] = (unsigned)(Rb * ldb + C) * 2u; }
    const size_t kstep = (size_t)(BK * 2);
    const size_t hstepB = (size_t)HALF * ldb * 2;
    const unsigned ldsw = (unsigned)wid * 1024u;
    const int aoff = lds_byte(wr * 64 + fr, fq * 8), boff = lds_byte(wc * 32 + fr, fq * 8);
#define G8_SA(b, h) (((b) * 2 + (h)) * HTB)
#define G8_SB(b, h) ((4 + (b) * 2 + (h)) * HTB)
#define G8_STAGE(bufoff, gbase, voff) do { _Pragma("unroll") for (int _i = 0; _i < 2; ++_i) \
        __builtin_amdgcn_global_load_lds((const unsigned*)((const char*)(gbase) + (voff)[_i]), (LAS unsigned*)(lds + (bufoff) + ldsw + _i * 8192), 16, 0, 0); } while (0)
#define G8_LDA(dst, b, h) do { _Pragma("unroll") for (int m = 0; m < 4; ++m) _Pragma("unroll") for (int k = 0; k < 2; ++k) dst[m][k] = *(const LAS bf16x8*)(lds + G8_SA(b, h) + aoff + m * 2048 + k * 1024); } while (0)
#define G8_LDB(dst, b, h) do { _Pragma("unroll") for (int n = 0; n < 2; ++n) _Pragma("unroll") for (int k = 0; k < 2; ++k) dst[n][k] = *(const LAS bf16x8*)(lds + G8_SB(b, h) + boff + n * 2048 + k * 1024); } while (0)
#define G8_MMA(ai, bj, At, Bt) do { __builtin_amdgcn_s_setprio(1); _Pragma("unroll") for (int m = 0; m < 4; ++m) _Pragma("unroll") for (int n = 0; n < 2; ++n) _Pragma("unroll") for (int k = 0; k < 2; ++k) \
        acc[ai][bj][m][n] = __builtin_amdgcn_mfma_f32_16x16x32_bf16(Bt[n][k], At[m][k], acc[ai][bj][m][n], 0, 0, 0); __builtin_amdgcn_s_setprio(0); } while (0)
#define G8_WAIT_V(n) asm volatile("s_waitcnt vmcnt(" #n ")" ::: "memory")
#define G8_WAIT_L(n) asm volatile("s_waitcnt lgkmcnt(" #n ")" ::: "memory")
#define G8_BAR __builtin_amdgcn_s_barrier()
#define G8_SCHED __builtin_amdgcn_sched_barrier(0)
    Unit cur, nxt; int ui = 0;
    if (!S.next(0, cur)) return;
    if (Sched::GATHER) {
#pragma unroll
        for (int i = 0; i < 2; ++i) S.gather(cur, RR[i], CC[i], voffA0[i], voffA1[i]);
    }
    f32x4 acc[2][2][4][2];
#pragma unroll
    for (int a = 0; a < 2; ++a)
#pragma unroll
        for (int b = 0; b < 2; ++b)
#pragma unroll
            for (int m = 0; m < 4; ++m)
#pragma unroll
                for (int n = 0; n < 2; ++n) acc[a][b][m][n] = (f32x4){0.f, 0.f, 0.f, 0.f};
    bf16x8 At[4][2], B0[2][2], B1[2][2];
    const char* cA = cur.A; const char* cB = cur.B;
    G8_STAGE(G8_SB(0, 0), cB, voffB); G8_STAGE(G8_SA(0, 0), cA, voffA0); G8_STAGE(G8_SB(0, 1), cB + hstepB, voffB); G8_STAGE(G8_SA(0, 1), cA, voffA1);
    if (wr == 1) G8_BAR;
    G8_WAIT_V(4); G8_BAR;
    G8_STAGE(G8_SB(1, 0), cB + kstep, voffB); G8_STAGE(G8_SA(1, 0), cA + kstep, voffA0); G8_STAGE(G8_SB(1, 1), cB + hstepB + kstep, voffB);
    G8_WAIT_V(6); G8_BAR;
    for (;;) {
        const bool has_next = S.next(ui + 1, nxt);
        const char* nA = has_next ? nxt.A : cA; const char* nB = has_next ? nxt.B : cB;
        unsigned nvA0[2], nvA1[2];
        if (Sched::GATHER) {
#pragma unroll
            for (int i = 0; i < 2; ++i) { nvA0[i] = voffA0[i]; nvA1[i] = voffA1[i]; if (has_next) S.gather(nxt, RR[i], CC[i], nvA0[i], nvA1[i]); }
        }
        const int nt = cur.nt;
        for (int t = 0; t < nt; t += 2) {
            const bool last = (t == nt - 2);
            const char* a1 = cA + (size_t)(t + 1) * kstep;
            const char* a2 = last ? nA : cA + (size_t)(t + 2) * kstep; const char* b2 = last ? nB : cB + (size_t)(t + 2) * kstep;
            const char* a3 = a2 + kstep; const char* b3 = b2 + kstep;
            G8_LDB(B0, 0, 0); G8_SCHED; G8_LDA(At, 0, 0); G8_STAGE(G8_SA(1, 1), a1, voffA1);
            if (Sched::GATHER) { if (last) {
#pragma unroll
                for (int i = 0; i < 2; ++i) { voffA0[i] = nvA0[i]; voffA1[i] = nvA1[i]; } } }
            G8_WAIT_L(8); G8_BAR; G8_WAIT_L(0); G8_MMA(0, 0, At, B0); G8_BAR; G8_SCHED;
            G8_LDB(B1, 0, 1); G8_STAGE(G8_SB(0, 0), b2, voffB);
            G8_BAR; G8_WAIT_L(0); G8_MMA(0, 1, At, B1); G8_BAR;
            G8_LDA(At, 0, 1); G8_STAGE(G8_SA(0, 0), a2, voffA0);
            G8_BAR; G8_WAIT_L(0); G8_MMA(1, 0, At, B0); G8_BAR; G8_SCHED;
            G8_STAGE(G8_SB(0, 1), b2 + hstepB, voffB);
            G8_WAIT_V(6); G8_BAR; G8_MMA(1, 1, At, B1); G8_BAR;
            G8_LDB(B0, 1, 0); G8_SCHED; G8_LDA(At, 1, 0); G8_STAGE(G8_SA(0, 1), a2, voffA1);
            G8_WAIT_L(8); G8_BAR; G8_WAIT_L(0); G8_MMA(0, 0, At, B0); G8_BAR; G8_SCHED;
            G8_LDB(B1, 1, 1); G8_STAGE(G8_SB(1, 0), b3, voffB);
            G8_BAR; G8_WAIT_L(0); G8_MMA(0, 1, At, B1); G8_BAR;
            G8_LDA(At, 1, 1); G8_STAGE(G8_SA(1, 0), a3, voffA0);
            G8_BAR; G8_WAIT_L(0); G8_MMA(1, 0, At, B0); G8_BAR; G8_SCHED;
            G8_STAGE(G8_SB(1, 1), b3 + hstepB, voffB);
            G8_WAIT_V(6); G8_BAR; G8_MMA(1, 1, At, B1); G8_BAR;
        }
        E(acc, cur, wr, wc, fr, fq);
        if (!has_next) break;
#pragma unroll
        for (int a = 0; a < 2; ++a)
#pragma unroll
            for (int b = 0; b < 2; ++b)
#pragma unroll
                for (int m = 0; m < 4; ++m)
#pragma unroll
                    for (int n = 0; n < 2; ++n) acc[a][b][m][n] = (f32x4){0.f, 0.f, 0.f, 0.f};
        cur = nxt; cA = nA; cB = nB; ++ui;
    }
    G8_WAIT_V(0);
    if (wr == 0) G8_BAR;
    G8_BAR;
#undef G8_SA
#undef G8_SB
#undef G8_STAGE
#undef G8_LDA
#undef G8_LDB
#undef G8_MMA
#undef G8_WAIT_V
#undef G8_WAIT_L
#undef G8_BAR
#undef G8_SCHED
}

__device__ __forceinline__ u32x4 pack8(const f32x4& v0, const f32x4& v1) { u32x4 w; w.x = cvt_pk_bf16(v0[0], v0[1]); w.y = cvt_pk_bf16(v0[2], v0[3]); w.z = cvt_pk_bf16(v1[0], v1[1]); w.w = cvt_pk_bf16(v1[2], v1[3]); return w; }
__device__ __forceinline__ void unpack8(const u32x4& w, f32x4& v0, f32x4& v1) { v0[0] = lo_bf(w.x); v0[1] = hi_bf(w.x); v0[2] = lo_bf(w.y); v0[3] = hi_bf(w.y); v1[0] = lo_bf(w.z); v1[1] = hi_bf(w.z); v1[2] = lo_bf(w.w); v1[3] = hi_bf(w.w); }
__device__ __forceinline__ f32x4 sig4(const f32x4& v) { f32x4 r; for (int j = 0; j < 4; ++j) r[j] = __builtin_amdgcn_rcpf(1.0f + __expf(-v[j])); return r; }

struct EpiInGate {
    static constexpr bool PERM = true;
    bf16_t* proj; bf16_t* gates; const float* bias;
    __device__ __forceinline__ void operator()(const f32x4 (&acc)[2][2][4][2], const Unit& u, int wr, int wc, int fr, int fq) const {
        const bool isg = u.col0 >= INW; const int colt = isg ? u.col0 - INW : u.col0; const int ldc = isg ? 4096 : INW; bf16_t* base = isg ? gates : proj;
        const int row0 = u.row0 + wr * 64 + fr, col0 = colt + wc * 32 + 8 * fq;
        f32x4 bv[2][2];
#pragma unroll
        for (int bj = 0; bj < 2; ++bj)
#pragma unroll
            for (int n = 0; n < 2; ++n) bv[bj][n] = isg ? *(const f32x4*)(bias + col0 + bj * HALF + 4 * n) : (f32x4){0.f, 0.f, 0.f, 0.f};
#pragma unroll
        for (int ai = 0; ai < 2; ++ai)
#pragma unroll
            for (int m = 0; m < 4; ++m) { bf16_t* rowp = base + (size_t)(row0 + ai * HALF + m * 16) * ldc + col0;
#pragma unroll
                for (int bj = 0; bj < 2; ++bj) { f32x4 v0 = acc[ai][bj][m][0] + bv[bj][0], v1 = acc[ai][bj][m][1] + bv[bj][1];
                    if (isg) { v0 = sig4(v0); v1 = sig4(v1); }
                    *(u32x4*)(rowp + bj * HALF) = pack8(v0, v1); } }
    }
};
struct EpiMerge {
    static constexpr bool PERM = true;
    bf16_t* merged; const bf16_t* gates;
    __device__ __forceinline__ void operator()(const f32x4 (&acc)[2][2][4][2], const Unit& u, int wr, int wc, int fr, int fq) const {
        const int row0 = u.row0 + wr * 64 + fr, col0 = u.col0 + wc * 32 + 8 * fq, b = u.e;
#pragma unroll
        for (int ai = 0; ai < 2; ++ai)
#pragma unroll
            for (int m = 0; m < 4; ++m) { const size_t row = (size_t)(row0 + ai * HALF + m * 16);
#pragma unroll
                for (int bj = 0; bj < 2; ++bj) { const int col = col0 + bj * HALF;
                    const u32x4 gw = *(const u32x4*)(gates + row * 4096 + b * 1024 + col); f32x4 g0, g1; unpack8(gw, g0, g1);
                    f32x4 v0 = acc[ai][bj][m][0] * g0, v1 = acc[ai][bj][m][1] * g1;
                    if (b > 0) { const u32x4 mw = *(const u32x4*)(merged + row * DM + col); f32x4 m0, m1; unpack8(mw, m0, m1); v0 += m0; v1 += m1; }
                    *(u32x4*)(merged + row * DM + col) = pack8(v0, v1); } }
    }
};
struct EpiResid {
    static constexpr bool PERM = true;
    bf16_t* x; const bf16_t* hb;
    __device__ __forceinline__ void operator()(const f32x4 (&acc)[2][2][4][2], const Unit& u, int wr, int wc, int fr, int fq) const {
        const int row0 = u.row0 + wr * 64 + fr, col0 = u.col0 + wc * 32 + 8 * fq;
#pragma unroll
        for (int ai = 0; ai < 2; ++ai)
#pragma unroll
            for (int m = 0; m < 4; ++m) { const size_t row = (size_t)(row0 + ai * HALF + m * 16);
#pragma unroll
                for (int bj = 0; bj < 2; ++bj) { const int col = col0 + bj * HALF;
                    const u32x4 hw = *(const u32x4*)(hb + row * DM + col); f32x4 h0, h1; unpack8(hw, h0, h1);
                    *(u32x4*)(x + row * DM + col) = pack8(acc[ai][bj][m][0] + h0 * ALPHA_F, acc[ai][bj][m][1] + h1 * ALPHA_F); } }
    }
};
struct EpiGateUp {
    static constexpr bool PERM = true;
    bf16_t* hid;
    __device__ __forceinline__ void operator()(const f32x4 (&acc)[2][2][4][2], const Unit& u, int wr, int wc, int fr, int fq) const {
        const int hc = (u.col0 >> 1) + wc * 32 + 8 * fq;
#pragma unroll
        for (int ai = 0; ai < 2; ++ai)
#pragma unroll
            for (int m = 0; m < 4; ++m) { const int rl = ai * HALF + wr * 64 + m * 16 + fr;
                if (rl < u.nvalid) { f32x4 v0, v1;
#pragma unroll
                    for (int j = 0; j < 4; ++j) { const float g0 = acc[ai][0][m][0][j], g1 = acc[ai][0][m][1][j];
                        v0[j] = g0 * __builtin_amdgcn_rcpf(1.0f + __expf(-g0)) * acc[ai][1][m][0][j]; v1[j] = g1 * __builtin_amdgcn_rcpf(1.0f + __expf(-g1)) * acc[ai][1][m][1][j]; }
                    *(u32x4*)(hid + (size_t)(u.row0 + rl) * EH + hc) = pack8(v0, v1); } }
    }
};
struct EpiDown {
    static constexpr bool PERM = true;
    bf16_t* outs; bf16_t* x; const bf16_t* hb;
    __device__ __forceinline__ void operator()(const f32x4 (&acc)[2][2][4][2], const Unit& u, int wr, int wc, int fr, int fq) const {
        const int col0 = u.col0 + wc * 32 + 8 * fq;
#pragma unroll
        for (int ai = 0; ai < 2; ++ai)
#pragma unroll
            for (int m = 0; m < 4; ++m) { const int rl = ai * HALF + wr * 64 + m * 16 + fr;
                if (rl < u.nvalid) { const size_t row = (size_t)(u.row0 + rl);
#pragma unroll
                    for (int bj = 0; bj < 2; ++bj) { const int col = col0 + bj * HALF;
                        if (u.e < 64) *(u32x4*)(outs + row * DM + col) = pack8(acc[ai][bj][m][0], acc[ai][bj][m][1]);
                        else { const size_t t = row - (size_t)8 * NTOK; const u32x4 hw = *(const u32x4*)(hb + t * DM + col); f32x4 h0, h1; unpack8(hw, h0, h1);
                            *(u32x4*)(x + t * DM + col) = pack8(acc[ai][bj][m][0] + h0 * ALPHA_F, acc[ai][bj][m][1] + h1 * ALPHA_F); } } } }
    }
};
}


namespace att {
typedef short bf16x8 __attribute__((ext_vector_type(8)));
typedef short s16x4 __attribute__((ext_vector_type(4)));
typedef float f32x16 __attribute__((ext_vector_type(16)));
typedef float f32x4 __attribute__((ext_vector_type(4)));
constexpr int KBUF = 8192, VBUF = 16384, TBUF = KBUF + VBUF;
constexpr int RPB_OFF = 4 * TBUF;
constexpr float LOG2E = 1.4426950408889634f;
#define ATT_TR(dst, addr, OFF) asm volatile("ds_read_b64_tr_b16 %0, %1 offset:%2" : "=&v"(dst) : "v"(addr), "i"(OFF) : "memory")
__device__ __forceinline__ unsigned pk2(float a, float b) { unsigned r; asm volatile("v_cvt_pk_bf16_f32 %0, %1, %2" : "=v"(r) : "v"(a), "v"(b)); return r; }

template <int MODE>
__device__ __forceinline__ void attn_unit(const Params& p, int l, int unit, LAS unsigned char* lds) {
    constexpr int NDB = MODE == 0 ? 4 : 2;
    int tid_ = TIDX; asm volatile("" : "+v"(tid_));
    const int tid = tid_, wid = __builtin_amdgcn_readfirstlane(tid >> 6), lane = tid & 63, lq = lane & 31, lh = lane >> 5;
    const bf16_t* proj = (const bf16_t*)(p.ws + OFF_PROJ); bf16_t* y = (bf16_t*)(p.ws + OFF_Y);
    const int b = unit >> 6, hd = (unit >> 4) & 3, qt = unit & 15;
    const int row0 = b * SEQ + qt * 256;
    const int qrow = row0 + wid * 32 + lq;
    const int qpos = qt * 256 + wid * 32 + lq;
    int t_lo, t_hi;
    int wr_lo = 0, wr_hi = 0;
    const int gr = qt * 4 + (wid >> 1);
    const int gc = (wid & 1) * 32 + lq;
    if (MODE == 0) { t_lo = 0; t_hi = SEQ / 64; }
    else { const int r0 = qt * 4; const int a = min(max(r0 - 4, 0), 56), c = min(max(r0 + 3 - 4, 0), 56) + 8; t_lo = a; t_hi = c;
           wr_lo = min(max(gr - 4, 0), 56); wr_hi = wr_lo + 8; }
    const int kcol = MODE == 0 ? (14 * 256 + hd * 128) : (5 * 256 + hd * 64);
    const int vcol = MODE == 0 ? (16 * 256 + hd * 128) : (6 * 256 + hd * 64);
    const int qcol = MODE == 0 ? (12 * 256 + hd * 128) : (4 * 256 + hd * 64);
    unsigned ksrc, vsrc0;
    { const int r = tid >> 3, pos = tid & 7, ch = pos ^ ((r >> 1) & 7); ksrc = (unsigned)(r * INW + kcol + ch * 8) * 2u; }
    if (MODE == 0) {
#pragma unroll
        for (int i = 0; i < 1; ++i) { const int A = 4 * i + (tid >> 7), B = (tid >> 5) & 3, Cc = (tid >> 2) & 7, Dd = tid & 3;
            const int r = 8 * A + Cc, ch = 4 * B + (Dd ^ (2 * (A & 1) + (Cc >> 2)));
            vsrc0 = (unsigned)(r * INW + vcol + ch * 8) * 2u; }
    } else { const int A = wid, B = lane >> 5, Cc = (lane >> 2) & 7, Dd = lane & 3; const int r = 8 * A + Cc, ch = 4 * B + (Dd ^ (2 * (A & 1) + (Cc >> 2)));
        vsrc0 = (unsigned)(r * INW + vcol + ch * 8) * 2u; }
    const char* kvbase = (const char*)(proj + (size_t)b * SEQ * INW);
#define ATT_DMA(tile, slot) do { const char* _g = kvbase + (size_t)(tile) * 64 * INW * 2; \
        __builtin_amdgcn_global_load_lds((const unsigned*)(_g + ksrc), (LAS unsigned*)(lds + (slot) * TBUF + wid * 1024), 16, 0, 0); \
        if (MODE == 0) { __builtin_amdgcn_global_load_lds((const unsigned*)(_g + vsrc0), (LAS unsigned*)(lds + (slot) * TBUF + KBUF + wid * 1024), 16, 0, 0); \
                         __builtin_amdgcn_global_load_lds((const unsigned*)(_g + vsrc0 + 32 * INW * 2), (LAS unsigned*)(lds + (slot) * TBUF + KBUF + 8192 + wid * 1024), 16, 0, 0); } \
        else           { __builtin_amdgcn_global_load_lds((const unsigned*)(_g + vsrc0), (LAS unsigned*)(lds + (slot) * TBUF + KBUF + wid * 2048), 16, 0, 0); } } while (0)
    const unsigned kaddr0 = (unsigned)(lq * 128 + 16 * (lh ^ ((lq >> 1) & 7)));
#define kaddr_(kk) (kaddr0 ^ (32u * (kk)))
    unsigned vaddr[2];
    { const int blk = (lane >> 4) & 1, q = (lane & 15) >> 2, pp = lane & 3;
#pragma unroll
      for (int t = 0; t < 2; ++t) vaddr[t] = (unsigned)(KBUF + 64 * (4 * lh + q) + 16 * ((2 * blk + (pp >> 1)) ^ (2 * t + lh)) + 8 * (pp & 1)); }
    const float slope2 = exp2f(-2.0f * (float)(hd + 1)) * LOG2E;
    unsigned kxw0, kxw1, qxw;
    { const unsigned short k0b = f2bf((float)lq), k1b = f2bf((float)(32 + lq));
      const unsigned short shi = f2bf(slope2), slo = f2bf(slope2 - bf2f(shi));
      kxw0 = lh ? 0u : ((unsigned)k0b | ((unsigned)k0b << 16)); kxw1 = lh ? 0u : ((unsigned)k1b | ((unsigned)k1b << 16));
      qxw = lh ? 0u : ((unsigned)shi | ((unsigned)slo << 16)); }
    float lam = 0.f, lam_init = 0.f;
    if (MODE == 0) { const float* lp = p.diff_lambda + (size_t)l * 256;
        const float s1 = wave_sum(lp[lane] * lp[64 + lane]), s2 = wave_sum(lp[128 + lane] * lp[192 + lane]);
        lam_init = 0.8f - 0.6f * __expf(-0.3f * (float)l); lam = __expf(s1) - __expf(s2) + lam_init; }
    if (MODE == 1) {
        const float* rp = p.nat_rpb + ((size_t)l * 4 + hd) * 15 * 31; LAS float* tb = (LAS float*)(lds + RPB_OFF);
        for (int i = tid; i < 15 * 64; i += NTHREADS) { const int dr = i >> 6, c = (i & 63) - 16; tb[i] = (c >= 0 && c < 31) ? rp[dr * 31 + c] * LOG2E : 0.f; }
    }
    unsigned* o1s = (unsigned*)(p.ws + OFF_DTMP) + (size_t)blockIdx.x * NTHREADS + tid;
    const size_t o1stride = (size_t)gridDim.x * NTHREADS;
    constexpr int NPASS = MODE == 0 ? 2 : 1;
#pragma unroll
    for (int pass = 0; pass < NPASS; ++pass) {
        bf16x8 qf[4];
        { const bf16_t* qp = proj + (size_t)qrow * INW + qcol + pass * 64 + 8 * lh;
#pragma unroll
          for (int kk = 0; kk < 4; ++kk) { const uint4 w = *(const uint4*)(qp + 16 * kk); const float sc = 0.125f * LOG2E;
              union { bf16x8 v; unsigned u[4]; } cv;
              cv.u[0] = pk2(lo_bf(w.x) * sc, hi_bf(w.x) * sc); cv.u[1] = pk2(lo_bf(w.y) * sc, hi_bf(w.y) * sc); cv.u[2] = pk2(lo_bf(w.z) * sc, hi_bf(w.z) * sc); cv.u[3] = pk2(lo_bf(w.w) * sc, hi_bf(w.w) * sc);
              qf[kk] = cv.v; } }
        if (MODE == 0 && pass == 1) { ksrc += 128u; }
        f32x16 o[NDB];
#pragma unroll
        for (int d = 0; d < NDB; ++d)
#pragma unroll
            for (int i = 0; i < 16; ++i) o[d][i] = 0.f;
        float m = -1e30f, lsum = 0.f;
        __syncthreads();
        ATT_DMA(t_lo, 0); if (t_lo + 1 < t_hi) ATT_DMA(t_lo + 1, 1);
        asm volatile("s_waitcnt vmcnt(0)" ::: "memory"); __syncthreads();
        const unsigned lbase = (unsigned)(uintptr_t)lds;
        const int qw0 = qt * 256 + wid * 32;
#define ATT_ACTIVE(tt) ((MODE == 0) || ((tt) >= wr_lo && (tt) < wr_hi))
#ifndef ATT_STAGGER
#define ATT_STAGGER 0
#endif
#ifndef ALIBI_MFMA
#define ALIBI_MFMA 0
#endif
#define ATT_TMODE(tt) (!ALIBI_MFMA ? 0 : ((tt) * 64 + 63 <= qw0) ? 1 : (((tt) * 64 >= qw0 + 31) ? -1 : 0))
#define ATT_QK(so, tt, S0, S1) do { \
            _Pragma("unroll") for (int i = 0; i < 16; ++i) { S0[i] = 0.f; S1[i] = 0.f; } \
            _Pragma("unroll") for (int kk = 0; kk < 4; ++kk) { \
                const bf16x8 a0 = *(const LAS bf16x8*)(lds + (so) + kaddr_(kk)), a1 = *(const LAS bf16x8*)(lds + (so) + kaddr_(kk) + 4096); \
                S0 = __builtin_amdgcn_mfma_f32_32x32x16_bf16(a0, qf[kk], S0, 0, 0, 0); S1 = __builtin_amdgcn_mfma_f32_32x32x16_bf16(a1, qf[kk], S1, 0, 0, 0); } \
            if (MODE == 0) { const int tm_ = ATT_TMODE(tt); if (tm_ != 0) { union { bf16x8 v; unsigned u[4]; } x0_, x1_, q_; \
                x0_.u[0] = kxw0; x1_.u[0] = kxw1; q_.u[0] = tm_ > 0 ? qxw : (qxw ^ 0x80008000u); x0_.u[1] = x0_.u[2] = x0_.u[3] = 0u; x1_.u[1] = x1_.u[2] = x1_.u[3] = 0u; q_.u[1] = q_.u[2] = q_.u[3] = 0u; \
                S0 = __builtin_amdgcn_mfma_f32_32x32x16_bf16(x0_.v, q_.v, S0, 0, 0, 0); S1 = __builtin_amdgcn_mfma_f32_32x32x16_bf16(x1_.v, q_.v, S1, 0, 0, 0); } } } while (0)
#define ATT_SM(tt, S0, S1) do { \
            float tmax = -3e38f, cl = 0.f; \
            if (MODE == 0) { const int tm_ = ATT_TMODE(tt); const float dq0 = (float)(qpos - (tt) * 64); \
                if (tm_ == 0) { const float dq = dq0 - (float)(4 * lh); \
                    _Pragma("unroll") for (int i = 0; i < 16; ++i) { const float c0 = (float)((i & 3) + 8 * (i >> 2)); \
                        S0[i] = S0[i] - slope2 * fabsf(dq - c0); S1[i] = S1[i] - slope2 * fabsf(dq - (c0 + 32.f)); } } \
                else cl = tm_ > 0 ? -slope2 * dq0 : slope2 * dq0; \
                _Pragma("unroll") for (int i = 0; i < 16; ++i) tmax = fmaxf(tmax, fmaxf(S0[i], S1[i])); \
                tmax += cl; \
            } else { \
                const LAS float* tb = (const LAS float*)(lds + RPB_OFF) + ((tt) - gr + 7) * 64 + 16 + 15 - gc + 4 * lh; \
                const int cs = min(max(gc - 8, 0), 48) - 4 * lh; \
                _Pragma("unroll") for (int i = 0; i < 16; ++i) { const int c0 = (i & 3) + 8 * (i >> 2); \
                    const bool v0 = (c0 >= cs) && (c0 < cs + 16), v1 = (c0 + 32 >= cs) && (c0 + 32 < cs + 16); \
                    S0[i] = v0 ? S0[i] + tb[c0] : -3e38f; S1[i] = v1 ? S1[i] + tb[c0 + 32] : -3e38f; \
                    tmax = fmaxf(tmax, fmaxf(S0[i], S1[i])); } \
            } \
            tmax = fmaxf(tmax, __shfl_xor(tmax, 32)); \
            const float mn = fmaxf(m, tmax); \
            if (__any(mn > m)) { const float al = __builtin_amdgcn_exp2f(m - mn); lsum *= al; \
                _Pragma("unroll") for (int d = 0; d < NDB; ++d) _Pragma("unroll") for (int i = 0; i < 16; ++i) o[d][i] *= al; \
                m = mn; } \
            const float mp = m - cl; float ps = 0.f; \
            _Pragma("unroll") for (int i = 0; i < 16; ++i) { S0[i] = __builtin_amdgcn_exp2f(S0[i] - mp); S1[i] = __builtin_amdgcn_exp2f(S1[i] - mp); ps += S0[i] + S1[i]; } \
            lsum += ps; \
            _Pragma("unroll") for (int ks = 0; ks < 4; ++ks) { union { bf16x8 v; unsigned u[4]; } cv; \
                _Pragma("unroll") for (int j = 0; j < 4; ++j) { const int i = 8 * (ks & 1) + 2 * j; cv.u[j] = (ks < 2) ? pk2(S0[i], S0[i + 1]) : pk2(S1[i], S1[i + 1]); } \
                pf[ks] = cv.v; } } while (0)
#define ATT_PV(so) do { \
            const unsigned vb0 = lbase + (so) + vaddr[0], vb1 = lbase + (so) + vaddr[1]; \
            _Pragma("unroll") for (int ks = 0; ks < 4; ++ks) { \
                s16x4 v0[NDB], v1[NDB]; \
                _Pragma("unroll") for (int d = 0; d < NDB; ++d) { \
                    if (ks == 0) { ATT_TR(v0[d], vb0, 0 * 4096 + d * 512); ATT_TR(v1[d], vb1, 0 * 4096 + 2048 + d * 512); } \
                    if (ks == 1) { ATT_TR(v0[d], vb0, 1 * 4096 + d * 512); ATT_TR(v1[d], vb1, 1 * 4096 + 2048 + d * 512); } \
                    if (ks == 2) { ATT_TR(v0[d], vb0, 2 * 4096 + d * 512); ATT_TR(v1[d], vb1, 2 * 4096 + 2048 + d * 512); } \
                    if (ks == 3) { ATT_TR(v0[d], vb0, 3 * 4096 + d * 512); ATT_TR(v1[d], vb1, 3 * 4096 + 2048 + d * 512); } } \
                if (NDB == 4) asm volatile("s_waitcnt lgkmcnt(0)" : "+v"(v0[0]), "+v"(v1[0]), "+v"(v0[1]), "+v"(v1[1]), "+v"(v0[2]), "+v"(v1[2]), "+v"(v0[3]), "+v"(v1[3]) :: "memory"); \
                else asm volatile("s_waitcnt lgkmcnt(0)" : "+v"(v0[0]), "+v"(v1[0]), "+v"(v0[1]), "+v"(v1[1]) :: "memory"); \
                _Pragma("unroll") for (int d = 0; d < NDB; ++d) { union { bf16x8 v; s16x4 h[2]; } cv; cv.h[0] = v0[d]; cv.h[1] = v1[d]; \
                    o[d] = __builtin_amdgcn_mfma_f32_32x32x16_bf16(cv.v, pf[ks], o[d], 0, 0, 0); } } } while (0)
        {
            f32x16 sa0, sa1; bf16x8 pf[4];
            const int grp = ATT_STAGGER ? (wid >> 2) : 0;
            for (int t = t_lo; t < t_hi; ++t) {
                const int st = (t - t_lo) & 3; const bool has = t + 2 < t_hi;
                if (has) ATT_DMA(t + 2, (st + 2) & 3);
                const bool act = ATT_ACTIVE(t);
                if (act) { ATT_QK(st * TBUF, t, sa0, sa1); ATT_SM(t, sa0, sa1); }
                if (grp == 1) { if (has) { if (MODE == 0) asm volatile("s_waitcnt vmcnt(3)" ::: "memory"); else asm volatile("s_waitcnt vmcnt(2)" ::: "memory"); } else asm volatile("s_waitcnt vmcnt(0)" ::: "memory"); __syncthreads(); }
                if (act) ATT_PV(st * TBUF);
                if (grp == 0) { if (has) { if (MODE == 0) asm volatile("s_waitcnt vmcnt(3)" ::: "memory"); else asm volatile("s_waitcnt vmcnt(2)" ::: "memory"); } else asm volatile("s_waitcnt vmcnt(0)" ::: "memory"); __syncthreads(); }
            }
        }
#undef ATT_SM
#undef ATT_PV
#undef ATT_QK
#undef ATT_TMODE
#undef ATT_ACTIVE
        const float ltot = lsum + __shfl_xor(lsum, 32), inv = 1.0f / ltot;
        if (MODE == 1) {
            bf16_t* yp = y + (size_t)qrow * 1280 + 256 + hd * 64 + 4 * lh;
#pragma unroll
            for (int d = 0; d < NDB; ++d)
#pragma unroll
                for (int g = 0; g < 4; ++g) { uint2 w; w.x = pk2(o[d][4 * g] * inv, o[d][4 * g + 1] * inv); w.y = pk2(o[d][4 * g + 2] * inv, o[d][4 * g + 3] * inv);
                    *(uint2*)(yp + 32 * d + 8 * g) = w; }
        } else if (pass == 0) {
#pragma unroll
            for (int d = 0; d < NDB; ++d)
#pragma unroll
                for (int i = 0; i < 8; ++i) o1s[(d * 8 + i) * o1stride] = pk2(o[d][2 * i] * inv, o[d][2 * i + 1] * inv);
        } else {
            float ss = 0.f;
#pragma unroll
            for (int d = 0; d < NDB; ++d)
#pragma unroll
                for (int i = 0; i < 8; ++i) { const unsigned w = o1s[(d * 8 + i) * o1stride];
                    const float a = lo_bf(w) - lam * o[d][2 * i] * inv, c = hi_bf(w) - lam * o[d][2 * i + 1] * inv; o[d][2 * i] = a; o[d][2 * i + 1] = c; ss += a * a + c * c; }
            ss += __shfl_xor(ss, 32);
            const float rs = rsqrtf(ss * (1.0f / 128.0f) + LN_EPS) * (1.0f - lam_init);
            const float* sl = p.diff_subln + (size_t)l * 512 + hd * 128 + 4 * lh;
            bf16_t* yp = y + (size_t)qrow * 1280 + 768 + hd * 128 + 4 * lh;
#pragma unroll
            for (int d = 0; d < NDB; ++d)
#pragma unroll
                for (int g = 0; g < 4; ++g) { const f32x4 sv = *(const f32x4*)(sl + 32 * d + 8 * g); uint2 w;
                    w.x = pk2(o[d][4 * g] * rs * sv[0], o[d][4 * g + 1] * rs * sv[1]); w.y = pk2(o[d][4 * g + 2] * rs * sv[2], o[d][4 * g + 3] * rs * sv[3]);
                    *(uint2*)(yp + 32 * d + 8 * g) = w; }
        }
    }
#undef ATT_DMA
#undef kaddr_
}
#undef ATT_TR
}


namespace rec {
typedef short bf16x8 __attribute__((ext_vector_type(8)));
typedef short s16x4 __attribute__((ext_vector_type(4)));
typedef float f32x16 __attribute__((ext_vector_type(16)));
typedef float f32x4 __attribute__((ext_vector_type(4)));
#define OFF_DS    OFF_EXPW
#define OFF_SP    (OFF_EXPW + 32 * MIB)
#define OFF_ADEC  (OFF_EXPW + 64 * MIB)
#define REC_TR(dst, addr, OFF) asm volatile("ds_read_b64_tr_b16 %0, %1 offset:%2" : "=&v"(dst) : "v"(addr), "i"(OFF) : "memory")
__device__ __forceinline__ unsigned offa(unsigned row, unsigned ch) { return 2048u * (row >> 3) + 512u * (ch >> 2) + 64u * (row & 7) + 16u * ((ch & 3) ^ ((row >> 2) & 3)); }
__device__ __forceinline__ unsigned offr(unsigned row, unsigned ch) { return row * 128u + 16u * (ch ^ ((row >> 1) & 7)); }
__device__ __forceinline__ unsigned pk2(float a, float b) { unsigned r; asm volatile("v_cvt_pk_bf16_f32 %0, %1, %2" : "=v"(r) : "v"(a), "v"(b)); return r; }

struct Gates { float lf[8], kk[8], qv[8], vv[8]; };
template <bool NEED_Q>
__device__ __forceinline__ void load_gates(const Params& p, int l, int m, int dir, int b, int h, int n, int c, int seg, Gates& G) {
    const bf16_t* proj = (const bf16_t*)(p.ws + OFF_PROJ);
    const int ch = h * 64 + c; const size_t tok0 = (size_t)b * SEQ + n * 64;
    float lb = 0.f, lfc = 0.f;
    if (m == 1) { if (l == 1) { const float a0 = p.hgrn_lb[(0 * 2 + dir) * 256 + ch], a1 = p.hgrn_lb[(1 * 2 + dir) * 256 + ch]; lb = 1.0f / (1.0f + __expf(a0 - a1)); } }
    else lfc = log1pf(-exp2f(-(float)(5 + dir + 2 * h)));
#pragma unroll
    for (int e = 0; e < 8; ++e) { const int ip = 8 * seg + e; const size_t tok = tok0 + (dir ? 63 - ip : ip); const bf16_t* pr = proj + tok * INW;
        if (m == 0) { G.lf[e] = lfc; G.kk[e] = bf2f(pr[256 + ch]) * 0.125f; G.vv[e] = bf2f(pr[512 + ch]); if (NEED_Q) G.qv[e] = bf2f(pr[ch]); }
        else { const float fp = bf2f(pr[(8 + dir) * 256 + ch]); const float sg = 1.0f / (1.0f + __expf(-fp));
               G.lf[e] = __logf(lb + (1.0f - lb) * sg); G.kk[e] = (1.0f - lb) * (1.0f - sg); G.vv[e] = bf2f(pr[10 * 256 + ch]);
               if (NEED_Q) { const float qq = bf2f(pr[7 * 256 + ch]); G.qv[e] = qq / (1.0f + __expf(-qq)); } } }
}

__device__ __forceinline__ void phase_a_unit(const Params& p, int l, int u, LAS unsigned char* lds) {
    int tid_ = TIDX; asm volatile("" : "+v"(tid_));
    const int tid = tid_, wid = __builtin_amdgcn_readfirstlane(tid >> 6), lane = tid & 63, c = lane, seg = wid;
    const int m = u >> 10, b = (u >> 8) & 3, h = (u >> 6) & 3, n = u & 63;
    LAS float* segsum = (LAS float*)(lds + 65536);
    Gates G[2]; float cs[2][8];
#pragma unroll
    for (int dir = 0; dir < 2; ++dir) { load_gates<false>(p, l, m, dir, b, h, n, c, seg, G[dir]);
        float a = 0.f;
#pragma unroll
        for (int e = 0; e < 8; ++e) { a += G[dir].lf[e]; cs[dir][e] = a; }
        segsum[(dir * 8 + seg) * 64 + c] = a; }
    __syncthreads();
#pragma unroll
    for (int dir = 0; dir < 2; ++dir) { float pre = 0.f, tot = 0.f;
#pragma unroll
        for (int s = 0; s < 8; ++s) { const float v = segsum[(dir * 8 + s) * 64 + c]; tot += v; pre += (s < seg) ? v : 0.f; }
        LAS unsigned char* tb = lds + dir * 16384;
#pragma unroll
        for (int e = 0; e < 8; ++e) { const int ip = 8 * seg + e; const float g = pre + cs[dir][e];
            const unsigned o = offa(ip, c >> 3) + (c & 7) * 2;
            *(LAS bf16_t*)(tb + o) = f2bf(G[dir].kk[e] * __expf(tot - g)); *(LAS bf16_t*)(tb + 1024 + o) = f2bf(G[dir].vv[e]); }
        if (seg == 0) { const int sq = ((m * 2 + dir) * 4 + b) * 4 + h; ((float*)(p.ws + OFF_ADEC))[((size_t)sq * 64 + n) * 64 + c] = __expf(tot); }
    }
    __syncthreads();
    { const int dir = wid >> 2, cb = (wid >> 1) & 1, vb = wid & 1; const unsigned lbase = (unsigned)(uintptr_t)lds + dir * 16384;
      const int lh = lane >> 5, blk = (lane >> 4) & 1, q = (lane & 15) >> 2, pp = lane & 3;
      f32x16 acc;
#pragma unroll
      for (int i = 0; i < 16; ++i) acc[i] = 0.f;
      unsigned aA[2], aB[2];
#pragma unroll
      for (int t = 0; t < 2; ++t) { const unsigned row = 8 * lh + 4 * t + q;
          aA[t] = lbase + offa(row, 4 * cb + 2 * blk + (pp >> 1)) + 8 * (pp & 1); aB[t] = lbase + 1024 + offa(row, 4 * vb + 2 * blk + (pp >> 1)) + 8 * (pp & 1); }
#pragma unroll
      for (int ks = 0; ks < 4; ++ks) { s16x4 a0, a1, b0, b1;
          if (ks == 0) { REC_TR(a0, aA[0], 0);     REC_TR(a1, aA[1], 0);     REC_TR(b0, aB[0], 0);     REC_TR(b1, aB[1], 0); }
          if (ks == 1) { REC_TR(a0, aA[0], 4096);  REC_TR(a1, aA[1], 4096);  REC_TR(b0, aB[0], 4096);  REC_TR(b1, aB[1], 4096); }
          if (ks == 2) { REC_TR(a0, aA[0], 8192);  REC_TR(a1, aA[1], 8192);  REC_TR(b0, aB[0], 8192);  REC_TR(b1, aB[1], 8192); }
          if (ks == 3) { REC_TR(a0, aA[0], 12288); REC_TR(a1, aA[1], 12288); REC_TR(b0, aB[0], 12288); REC_TR(b1, aB[1], 12288); }
          asm volatile("s_waitcnt lgkmcnt(0)" : "+v"(a0), "+v"(a1), "+v"(b0), "+v"(b1) :: "memory");
          union { bf16x8 v; s16x4 hh[2]; } ua, ub; ua.hh[0] = a0; ua.hh[1] = a1; ub.hh[0] = b0; ub.hh[1] = b1;
          acc = __builtin_amdgcn_mfma_f32_32x32x16_bf16(ua.v, ub.v, acc, 0, 0, 0); }
      const int sq = ((m * 2 + dir) * 4 + b) * 4 + h;
      bf16_t* ds = (bf16_t*)(p.ws + OFF_DS) + ((size_t)sq * 64 + n) * 4096 + 32 * vb + (lane & 31);
#pragma unroll
      for (int i = 0; i < 16; ++i) { const int cc = 32 * cb + (i & 3) + 8 * (i >> 2) + 4 * lh; ds[cc * 64] = f2bf(acc[i]); } }
    __syncthreads();
}

__device__ __forceinline__ void phase_b(const Params& p) {
    const int e2 = GTID; if (e2 >= 64 * 2048) return;
    const int sq = e2 >> 11, pr = e2 & 2047, c = pr >> 5, v2 = (pr & 31) * 2, dir = (sq >> 4) & 1;
    const unsigned* ds = (const unsigned*)(p.ws + OFF_DS) + (((size_t)sq * 64) * 4096 + c * 64 + v2) / 2;
    unsigned* sp = (unsigned*)(p.ws + OFF_SP) + (((size_t)sq * 64) * 4096 + c * 64 + v2) / 2;
    const float* ad = (const float*)(p.ws + OFF_ADEC) + (size_t)sq * 64 * 64 + c;
    float s0 = 0.f, s1 = 0.f;
    for (int n0 = 0; n0 < 64; n0 += 8) { unsigned d[8]; float a[8];
#pragma unroll
        for (int j = 0; j < 8; ++j) { const int n = dir ? 63 - (n0 + j) : n0 + j; d[j] = ds[(size_t)n * 2048]; a[j] = ad[n * 64]; }
#pragma unroll
        for (int j = 0; j < 8; ++j) { const int n = dir ? 63 - (n0 + j) : n0 + j; sp[(size_t)n * 2048] = pk2(s0, s1); s0 = a[j] * s0 + lo_bf(d[j]); s1 = a[j] * s1 + hi_bf(d[j]); } }
}

__device__ __forceinline__ void phase_c_unit(const Params& p, int l, int u, LAS unsigned char* lds) {
    int tid_ = TIDX; asm volatile("" : "+v"(tid_));
    const int tid = tid_, wid = __builtin_amdgcn_readfirstlane(tid >> 6), lane = tid & 63, c = lane, seg = wid;
    const int m = u >> 10, b = (u >> 8) & 3, h = (u >> 6) & 3, n = u & 63;
    LAS float* segsum = (LAS float*)(lds + 114688);
    LAS float* outt = (LAS float*)(lds + 81920);
    {
        const int r = tid >> 3, chn = tid & 7;
#pragma unroll
        for (int dir = 0; dir < 2; ++dir) { const int sq = ((m * 2 + dir) * 4 + b) * 4 + h;
            typedef unsigned u32x4v __attribute__((ext_vector_type(4)));
            const u32x4v w = *(const u32x4v*)((const bf16_t*)(p.ws + OFF_SP) + ((size_t)sq * 64 + n) * 4096 + r * 64 + chn * 8);
            *(LAS u32x4v*)(lds + dir * 40960 + 24576 + 1024 + offa(r, chn)) = w; } }
    Gates G[2]; float cs[2][8];
#pragma unroll
    for (int dir = 0; dir < 2; ++dir) { load_gates<true>(p, l, m, dir, b, h, n, c, seg, G[dir]);
        float a = 0.f;
#pragma unroll
        for (int e = 0; e < 8; ++e) { a += G[dir].lf[e]; cs[dir][e] = a; }
        segsum[(dir * 8 + seg) * 64 + c] = a; }
    __syncthreads();
#pragma unroll
    for (int dir = 0; dir < 2; ++dir) { float pre = 0.f, gref = 0.f;
#pragma unroll
        for (int s = 0; s < 8; ++s) { const float v = segsum[(dir * 8 + s) * 64 + c]; pre += (s < seg) ? v : 0.f; gref += (s < 4) ? v : 0.f; }
        LAS unsigned char* tb = lds + dir * 40960;
#pragma unroll
        for (int e = 0; e < 8; ++e) { const int ip = 8 * seg + e; const float g = pre + cs[dir][e];
            const unsigned orow = offr(ip, c >> 3) + (c & 7) * 2, oa = offa(ip, c >> 3) + (c & 7) * 2;
            *(LAS bf16_t*)(tb + orow) = f2bf(G[dir].kk[e] * __expf(gref - g));
            *(LAS bf16_t*)(tb + 8192 + orow) = f2bf(G[dir].qv[e] * __expf(g - gref));
            *(LAS bf16_t*)(tb + 16384 + orow) = f2bf(G[dir].qv[e] * __expf(g));
            *(LAS bf16_t*)(tb + 24576 + oa) = f2bf(G[dir].vv[e]); }
    }
    __syncthreads();
    { const int dir = wid >> 2, ib = (wid >> 1) & 1, db = wid & 1; LAS unsigned char* tb = lds + dir * 40960; const unsigned lbase = (unsigned)(uintptr_t)tb;
      const int lq = lane & 31, lh = lane >> 5, blk = (lane >> 4) & 1, q = (lane & 15) >> 2, pp = lane & 3;
      f32x16 o;
#pragma unroll
      for (int i = 0; i < 16; ++i) o[i] = 0.f;
      bf16x8 qt[4], qh[4];
#pragma unroll
      for (int kk = 0; kk < 4; ++kk) { const unsigned a = offr(32 * ib + lq, 2 * kk + lh); qt[kk] = *(const LAS bf16x8*)(tb + 8192 + a); qh[kk] = *(const LAS bf16x8*)(tb + 16384 + a); }
#pragma unroll
      for (int kb = 0; kb < 2; ++kb) { if (kb <= ib) {
          f32x16 s;
#pragma unroll
          for (int i = 0; i < 16; ++i) s[i] = 0.f;
#pragma unroll
          for (int kk = 0; kk < 4; ++kk) { const bf16x8 a = *(const LAS bf16x8*)(tb + offr(32 * kb + lq, 2 * kk + lh)); s = __builtin_amdgcn_mfma_f32_32x32x16_bf16(a, qt[kk], s, 0, 0, 0); }
          const int iq = 32 * ib + lq;
#pragma unroll
          for (int i = 0; i < 16; ++i) { const int jk = 32 * kb + (i & 3) + 8 * (i >> 2) + 4 * lh; s[i] = (jk <= iq) ? s[i] : 0.f; }
#pragma unroll
          for (int sx = 0; sx < 2; ++sx) { union { bf16x8 v; unsigned uu[4]; } pf;
#pragma unroll
              for (int j = 0; j < 4; ++j) pf.uu[j] = pk2(s[8 * sx + 2 * j], s[8 * sx + 2 * j + 1]);
              s16x4 v0, v1; const unsigned ks = 2 * kb + sx;
              const unsigned a0 = lbase + 24576 + offa(16 * ks + 0 + 4 * lh + q, 4 * db + 2 * blk + (pp >> 1)) + 8 * (pp & 1);
              const unsigned a1 = lbase + 24576 + offa(16 * ks + 8 + 4 * lh + q, 4 * db + 2 * blk + (pp >> 1)) + 8 * (pp & 1);
              REC_TR(v0, a0, 0); REC_TR(v1, a1, 0);
              asm volatile("s_waitcnt lgkmcnt(0)" : "+v"(v0), "+v"(v1) :: "memory");
              union { bf16x8 v; s16x4 hh[2]; } uv; uv.hh[0] = v0; uv.hh[1] = v1;
              o = __builtin_amdgcn_mfma_f32_32x32x16_bf16(uv.v, pf.v, o, 0, 0, 0); } } }
#pragma unroll
      for (int kk = 0; kk < 4; ++kk) { s16x4 v0, v1;
          const unsigned a0 = lbase + 24576 + 1024 + offa(16 * kk + 8 * lh + 0 + q, 4 * db + 2 * blk + (pp >> 1)) + 8 * (pp & 1);
          const unsigned a1 = lbase + 24576 + 1024 + offa(16 * kk + 8 * lh + 4 + q, 4 * db + 2 * blk + (pp >> 1)) + 8 * (pp & 1);
          REC_TR(v0, a0, 0); REC_TR(v1, a1, 0);
          asm volatile("s_waitcnt lgkmcnt(0)" : "+v"(v0), "+v"(v1) :: "memory");
          union { bf16x8 v; s16x4 hh[2]; } uv; uv.hh[0] = v0; uv.hh[1] = v1;
          o = __builtin_amdgcn_mfma_f32_32x32x16_bf16(uv.v, qh[kk], o, 0, 0, 0); }
      const int ipq = 32 * ib + lq, tokl = dir ? 63 - ipq : ipq;
#pragma unroll
      for (int g = 0; g < 4; ++g) { f32x4 w; w[0] = o[4 * g]; w[1] = o[4 * g + 1]; w[2] = o[4 * g + 2]; w[3] = o[4 * g + 3];
          *(LAS f32x4*)(outt + (dir * 64 + tokl) * 64 + 32 * db + 8 * g + 4 * lh) = w; } }
    __syncthreads();
    { const int i = tid >> 3, vs = (tid & 7) * 8; const size_t tok = (size_t)b * SEQ + n * 64 + i;
      float o[8]; float ss = 0.f;
#pragma unroll
      for (int j = 0; j < 8; ++j) { o[j] = outt[i * 64 + vs + j] + outt[(64 + i) * 64 + vs + j]; ss += o[j] * o[j]; }
      ss += __shfl_xor(ss, 1); ss += __shfl_xor(ss, 2); ss += __shfl_xor(ss, 4);
      const float rs = rsqrtf(ss * (1.0f / 64.0f) + LN_EPS);
      const float* gn = (m == 0 ? p.ret_gn : p.hgrn_gn) + (size_t)l * 256 + h * 64 + vs;
      const bf16_t* gp = (const bf16_t*)(p.ws + OFF_PROJ) + tok * INW + (m == 0 ? 3 : 11) * 256 + h * 64 + vs;
      const uint4 gw = *(const uint4*)gp; const unsigned gwa[4] = {gw.x, gw.y, gw.z, gw.w}; unsigned ow[4];
#pragma unroll
      for (int j = 0; j < 4; ++j) { const float g0 = lo_bf(gwa[j]), g1 = hi_bf(gwa[j]);
          ow[j] = pk2(o[2 * j] * rs * gn[2 * j] * (g0 / (1.0f + __expf(-g0))), o[2 * j + 1] * rs * gn[2 * j + 1] * (g1 / (1.0f + __expf(-g1)))); }
      *(uint4*)((bf16_t*)(p.ws + OFF_Y) + tok * 1280 + (m == 0 ? 0 : 512) + h * 64 + vs) = make_uint4(ow[0], ow[1], ow[2], ow[3]); }
    __syncthreads();
}
#undef REC_TR
}

__device__ __forceinline__ void ph_conv_mixer_weights(const Params& p, int l, bf16_t* tile) {
    bf16_t* wtig = (bf16_t*)(p.ws + OFF_WTIG); bf16_t* wtbr = (bf16_t*)(p.ws + OFF_WTBR); bf16_t* wtout = (bf16_t*)(p.ws + OFF_WTOUT);
    const int n_in = 1152, n_gate = 1024, n_br = 64, n_bd = 128, n_out = 256;
    const int total = n_in + n_gate + 3 * n_br + n_bd + n_out;
    for (int j = blockIdx.x; j < total; j += gridDim.x) {
        int q = j;
        if (q < n_in) { const int kt = q & 15, nt = q >> 4; tconv_tile(p.w_in + (size_t)l * DM * INW, INW, kt * 64, nt * 64, wtig, DM, nt * 64, kt * 64, tile); continue; }
        q -= n_in;
        if (q < n_gate) { const int kt = q & 15, nt = q >> 4; tconv_tile(p.w_gate + (size_t)l * DM * 4096, 4096, kt * 64, nt * 64, wtig, DM, INW + nt * 64, kt * 64, tile); continue; }
        q -= n_gate;
        if (q < 3 * n_br) { const int which = q / n_br, r = q % n_br, kt = r & 3, nt = r >> 2;
            const float* src = (which == 0 ? p.w_br_ret : which == 1 ? p.w_br_nat : p.w_br_hgrn) + (size_t)l * 256 * DM;
            tconv_tile(src, DM, kt * 64, nt * 64, wtbr, 1280, nt * 64, which * 256 + kt * 64, tile); continue; }
        q -= 3 * n_br;
        if (q < n_bd) { const int kt = q & 7, nt = q >> 3; tconv_tile(p.w_br_diff + (size_t)l * 512 * DM, DM, kt * 64, nt * 64, wtbr, 1280, nt * 64, 768 + kt * 64, tile); continue; }
        q -= n_bd;
        { const int kt = q & 15, nt = q >> 4; tconv_tile(p.w_out + (size_t)l * DM * DM, DM, kt * 64, nt * 64, wtout, DM, nt * 64, kt * 64, tile); }
    }
}
__device__ __forceinline__ void ph_conv_expert_weights(const Params& p, int l, bf16_t* tile) {
    bf16_t* gu = (bf16_t*)(p.ws + OFF_EXPGU); bf16_t* dn = (bf16_t*)(p.ws + OFF_EXPDN);
    const int per_gu = 128, per_dn = 64, total = 65 * (per_gu + per_dn);
    for (int j = blockIdx.x; j < total; j += gridDim.x) {
        const int e = j / (per_gu + per_dn); int q = j % (per_gu + per_dn);
        if (q < per_gu) {
            const int kt = q & 15, nt = (q >> 4) & 1, blk = q >> 5;
            const float* src = (e < 64) ? (((blk & 1) ? p.w_e_up : p.w_e_gate) + ((size_t)l * NEXP + e) * DM * EH) : (((blk & 1) ? p.w_s_up : p.w_s_gate) + (size_t)l * DM * EH);
            tconv_tile(src, EH, kt * 64, (blk >> 1) * 128 + nt * 64, gu + (size_t)e * 512 * DM, DM, blk * 128 + nt * 64, kt * 64, tile);
        } else { q -= per_gu;
            const int kt = q & 3, nt = q >> 2;
            const float* src = (e < 64) ? (p.w_e_down + ((size_t)l * NEXP + e) * EH * DM) : (p.w_s_down + (size_t)l * EH * DM);
            tconv_tile(src, DM, kt * 64, nt * 64, dn + (size_t)e * DM * EH, EH, nt * 64, kt * 64, tile);
        }
    }
}

__device__ __forceinline__ void ph_ln_in(const Params& p) {
    bf16_t* hb = (bf16_t*)(p.ws + OFF_HB);
    const int lane = TIDX & 63, gw = GTID >> 6, nw = GSIZE >> 6;
    for (int row = gw; row < NTOK; row += nw) {
        const float* xr = p.x + (size_t)row * DM;
        float4 v[4]; float s = 0.f;
#pragma unroll
        for (int i = 0; i < 4; ++i) { v[i] = *(const float4*)(xr + i * 256 + lane * 4); s += v[i].x + v[i].y + v[i].z + v[i].w; }
        const float mu = wave_sum(s) * (1.0f / DM); float q = 0.f;
#pragma unroll
        for (int i = 0; i < 4; ++i) { v[i].x -= mu; v[i].y -= mu; v[i].z -= mu; v[i].w -= mu; q += v[i].x * v[i].x + v[i].y * v[i].y + v[i].z * v[i].z + v[i].w * v[i].w; }
        const float rs = rsqrtf(wave_sum(q) * (1.0f / DM) + LN_EPS);
#pragma unroll
        for (int i = 0; i < 4; ++i) { const int c = i * 256 + lane * 4;
            const float4 g = *(const float4*)(p.ln_in_g + c), b = *(const float4*)(p.ln_in_b + c);
            ushort4 o; o.x = f2bf(v[i].x * rs * g.x + b.x); o.y = f2bf(v[i].y * rs * g.y + b.y); o.z = f2bf(v[i].z * rs * g.z + b.z); o.w = f2bf(v[i].w * rs * g.w + b.w);
            *(ushort4*)(hb + (size_t)row * DM + c) = o; }
    }
}

__device__ __forceinline__ void ph_inproj_naive(const Params& p, int l) {
    const bf16_t* hb = (const bf16_t*)(p.ws + OFF_HB); const bf16_t* wt = (const bf16_t*)(p.ws + OFF_WTIG);
    bf16_t* proj = (bf16_t*)(p.ws + OFF_PROJ); bf16_t* gates = (bf16_t*)(p.ws + OFF_GATES);
    const float* bg = p.b_gate + (size_t)l * 4096;
    const long total = (long)NTOK * 8704;
    for (long it = GTID; it < total; it += GSIZE) {
        const int col = (int)(it % 8704), row = (int)(it / 8704);
        const float acc = dot_bf16(hb + (size_t)row * DM, wt + (size_t)col * DM, DM);
        if (col < INW) proj[(size_t)row * INW + col] = f2bf(acc);
        else gates[(size_t)row * 4096 + (col - INW)] = f2bf(sigmoidf_(acc + bg[col - INW]));
    }
}

__device__ __forceinline__ void ph_recur_naive(const Params& p, int l) {
    if (blockIdx.x >= 64 || TIDX >= 64) return;
    const int seq = blockIdx.x, lane = TIDX;
    const int m = seq >> 5, dir = (seq >> 4) & 1, b = (seq >> 2) & 3, h = seq & 3;
    const bf16_t* proj = (const bf16_t*)(p.ws + OFF_PROJ);
    float* otmp = (float*)(p.ws + OFF_OTMP) + (size_t)(m * 2 + dir) * NTOK * 256;
    float S[64];
#pragma unroll
    for (int k = 0; k < 64; ++k) S[k] = 0.f;
    const int ch = h * 64 + lane;
    float lb = 0.f;
    if (m == 1 && l == 1) { const float a0 = p.hgrn_lb[(0 * 2 + dir) * 256 + ch], a1 = p.hgrn_lb[(1 * 2 + dir) * 256 + ch]; lb = 1.0f / (1.0f + __expf(a0 - a1)); }
    const float fret = 1.0f - exp2f(-(dir ? 6.0f : 5.0f) - 2.0f * (float)h);
    for (int s = 0; s < SEQ; ++s) {
        const int tt = dir ? (SEQ - 1 - s) : s; const size_t row = (size_t)b * SEQ + tt;
        const bf16_t* pr = proj + row * INW;
        float qv, kv, vv, fv;
        if (m == 0) { qv = bf2f(pr[ch]); kv = bf2f(pr[256 + ch]) * 0.125f; vv = bf2f(pr[512 + ch]); fv = fret; }
        else { qv = siluf_(bf2f(pr[7 * 256 + ch])); const float fp = bf2f(pr[(8 + dir) * 256 + ch]);
               fv = lb + (1.0f - lb) * sigmoidf_(fp); kv = (1.0f - lb) * sigmoidf_(-fp); vv = bf2f(pr[10 * 256 + ch]); }
        float o = 0.f;
#pragma unroll
        for (int k = 0; k < 64; ++k) {
            const float fk = __int_as_float(__builtin_amdgcn_readlane(__float_as_int(fv), k));
            const float kk = __int_as_float(__builtin_amdgcn_readlane(__float_as_int(kv), k));
            const float qk = __int_as_float(__builtin_amdgcn_readlane(__float_as_int(qv), k));
            S[k] = fk * S[k] + kk * vv; o += S[k] * qk;
        }
        otmp[row * 256 + ch] = o;
    }
}
__device__ __forceinline__ void ph_recur_finish(const Params& p, int l) {
    const bf16_t* proj = (const bf16_t*)(p.ws + OFF_PROJ); bf16_t* y = (bf16_t*)(p.ws + OFF_Y);
    const float* otmp = (const float*)(p.ws + OFF_OTMP);
    const int lane = TIDX & 63, gw = GTID >> 6, nw = GSIZE >> 6;
    for (int it = gw; it < NTOK * 8; it += nw) {
        const int h = it & 3, m = (it >> 2) & 1, row = it >> 3, ch = h * 64 + lane;
        const float o = otmp[((size_t)(m * 2 + 0) * NTOK + row) * 256 + ch] + otmp[((size_t)(m * 2 + 1) * NTOK + row) * 256 + ch];
        const float ms = wave_sum(o * o) * (1.0f / 64.0f);
        const float gn = (m == 0 ? p.ret_gn : p.hgrn_gn)[(size_t)l * 256 + ch];
        const float g = bf2f(proj[(size_t)row * INW + (m == 0 ? 3 : 11) * 256 + ch]);
        y[(size_t)row * 1280 + (m == 0 ? 0 : 512) + ch] = f2bf(o * rsqrtf(ms + LN_EPS) * gn * siluf_(g));
    }
}

__device__ __forceinline__ void ph_nat_naive(const Params& p, int l) {
    const bf16_t* proj = (const bf16_t*)(p.ws + OFF_PROJ); bf16_t* y = (bf16_t*)(p.ws + OFF_Y);
    const float* rpb = p.nat_rpb + (size_t)l * 4 * 15 * 31;
    for (int it = GTID; it < NTOK * 4; it += GSIZE) {
        const int row = it % NTOK, h = it / NTOK;
        const int b = row >> 12, r = (row >> 6) & 63, c = row & 63;
        const int rs = min(max(r - 4, 0), 56), cs = min(max(c - 8, 0), 48);
        float q[64], acc[64];
        { const bf16_t* qp = proj + (size_t)row * INW + 4 * 256 + h * 64;
#pragma unroll
          for (int d = 0; d < 64; ++d) { q[d] = bf2f(qp[d]); acc[d] = 0.f; } }
        float mx = -1e30f, lsum = 0.f;
        for (int kr = 0; kr < 8; ++kr) for (int kc = 0; kc < 16; ++kc) {
            const int rr = rs + kr, cc = cs + kc; const size_t krow = (size_t)b * SEQ + rr * 64 + cc;
            const bf16_t* kp = proj + krow * INW + 5 * 256 + h * 64; const bf16_t* vp = proj + krow * INW + 6 * 256 + h * 64;
            float s = 0.f;
#pragma unroll
            for (int d = 0; d < 64; ++d) s += q[d] * bf2f(kp[d]);
            int dc = cc - c; dc = min(max(dc, -15), 15) + 15;
            s = s * 0.125f + rpb[(h * 15 + (rr - r + 7)) * 31 + dc];
            const float mn = fmaxf(mx, s), sc = __expf(mx - mn), pe = __expf(s - mn);
            lsum = lsum * sc + pe; mx = mn;
#pragma unroll
            for (int d = 0; d < 64; ++d) acc[d] = acc[d] * sc + pe * bf2f(vp[d]);
        }
        const float inv = 1.0f / lsum;
        bf16_t* yp = y + (size_t)row * 1280 + 256 + h * 64;
#pragma unroll
        for (int d = 0; d < 64; ++d) yp[d] = f2bf(acc[d] * inv);
    }
}

__device__ __forceinline__ void ph_diff_naive(const Params& p, int l) {
    const bf16_t* proj = (const bf16_t*)(p.ws + OFF_PROJ); bf16_t* dt = (bf16_t*)(p.ws + OFF_DTMP);
    for (int it = GTID; it < NTOK * 32; it += GSIZE) {
        const int row = it % NTOK, grp = it / NTOK;
        const int dvq = grp & 3, j = (grp >> 2) & 1, h = grp >> 3;
        const int b = row >> 12, qpos = row & 4095;
        const float slope = exp2f(-2.0f * (float)(h + 1));
        float q[64], acc[32];
        { const bf16_t* qp = proj + (size_t)row * INW + 12 * 256 + h * 128 + j * 64;
#pragma unroll
          for (int d = 0; d < 64; ++d) q[d] = bf2f(qp[d]) * 0.125f;
#pragma unroll
          for (int d = 0; d < 32; ++d) acc[d] = 0.f; }
        float mx = -1e30f, lsum = 0.f;
        for (int kpos = 0; kpos < SEQ; ++kpos) {
            const size_t krow = (size_t)b * SEQ + kpos;
            const bf16_t* kp = proj + krow * INW + 14 * 256 + h * 128 + j * 64; const bf16_t* vp = proj + krow * INW + 16 * 256 + h * 128 + dvq * 32;
            float s = 0.f;
#pragma unroll
            for (int d = 0; d < 64; d += 8) { const uint4 kv = *(const uint4*)(kp + d);
                s += q[d] * lo_bf(kv.x) + q[d + 1] * hi_bf(kv.x) + q[d + 2] * lo_bf(kv.y) + q[d + 3] * hi_bf(kv.y) + q[d + 4] * lo_bf(kv.z) + q[d + 5] * hi_bf(kv.z) + q[d + 6] * lo_bf(kv.w) + q[d + 7] * hi_bf(kv.w); }
            s -= slope * fabsf((float)(qpos - kpos));
            if (s > mx) { const float sc = __expf(mx - s); lsum *= sc;
#pragma unroll
                for (int d = 0; d < 32; ++d) acc[d] *= sc;
                mx = s; }
            const float pe = __expf(s - mx); lsum += pe;
#pragma unroll
            for (int d = 0; d < 32; d += 8) { const uint4 vv = *(const uint4*)(vp + d);
                acc[d] += pe * lo_bf(vv.x); acc[d + 1] += pe * hi_bf(vv.x); acc[d + 2] += pe * lo_bf(vv.y); acc[d + 3] += pe * hi_bf(vv.y);
                acc[d + 4] += pe * lo_bf(vv.z); acc[d + 5] += pe * hi_bf(vv.z); acc[d + 6] += pe * lo_bf(vv.w); acc[d + 7] += pe * hi_bf(vv.w); }
        }
        const float inv = 1.0f / lsum;
        bf16_t* op = dt + (((size_t)row * 4 + h) * 2 + j) * 128 + dvq * 32;
#pragma unroll
        for (int d = 0; d < 32; ++d) op[d] = f2bf(acc[d] * inv);
    }
}
__device__ __forceinline__ void ph_diff_finish(const Params& p, int l) {
    const bf16_t* dt = (const bf16_t*)(p.ws + OFF_DTMP); bf16_t* y = (bf16_t*)(p.ws + OFF_Y);
    const int lane = TIDX & 63, gw = GTID >> 6, nw = GSIZE >> 6;
    const float* lp = p.diff_lambda + (size_t)l * 256;
    const float s1 = wave_sum(lp[lane] * lp[64 + lane]), s2 = wave_sum(lp[128 + lane] * lp[192 + lane]);
    const float lam_init = 0.8f - 0.6f * __expf(-0.3f * (float)l);
    const float lam = __expf(s1) - __expf(s2) + lam_init;
    for (int it = gw; it < NTOK * 4; it += nw) {
        const int h = it & 3, row = it >> 2;
        const bf16_t* o1 = dt + (((size_t)row * 4 + h) * 2 + 0) * 128; const bf16_t* o2 = o1 + 128;
        const float a = bf2f(o1[lane]) - lam * bf2f(o2[lane]), c = bf2f(o1[64 + lane]) - lam * bf2f(o2[64 + lane]);
        const float ms = wave_sum(a * a + c * c) * (1.0f / 128.0f), rs = rsqrtf(ms + LN_EPS) * (1.0f - lam_init);
        const float* sl = p.diff_subln + (size_t)l * 512 + h * 128;
        bf16_t* yp = y + (size_t)row * 1280 + 768 + h * 128;
        yp[lane] = f2bf(a * rs * sl[lane]); yp[64 + lane] = f2bf(c * rs * sl[64 + lane]);
    }
}

__device__ __forceinline__ void ph_merge_naive(const Params& p) {
    const bf16_t* y = (const bf16_t*)(p.ws + OFF_Y); const bf16_t* gates = (const bf16_t*)(p.ws + OFF_GATES); const bf16_t* wt = (const bf16_t*)(p.ws + OFF_WTBR);
    bf16_t* mg = (bf16_t*)(p.ws + OFF_MERGED);
    for (int it = GTID; it < NTOK * DM; it += GSIZE) {
        const int col = it & 1023, row = it >> 10;
        const bf16_t* yr = y + (size_t)row * 1280; const bf16_t* wr = wt + (size_t)col * 1280; const bf16_t* gr = gates + (size_t)row * 4096 + col;
        const float v = bf2f(gr[0]) * dot_bf16(yr, wr, 256) + bf2f(gr[1024]) * dot_bf16(yr + 256, wr + 256, 256)
                      + bf2f(gr[2048]) * dot_bf16(yr + 512, wr + 512, 256) + bf2f(gr[3072]) * dot_bf16(yr + 768, wr + 768, 512);
        mg[(size_t)row * DM + col] = f2bf(v);
    }
}
__device__ __forceinline__ void ph_outproj_naive(const Params& p) {
    const bf16_t* mg = (const bf16_t*)(p.ws + OFF_MERGED); const bf16_t* wt = (const bf16_t*)(p.ws + OFF_WTOUT); const bf16_t* hb = (const bf16_t*)(p.ws + OFF_HB);
    bf16_t* x = (bf16_t*)(p.ws + OFF_X);
    for (int it = GTID; it < NTOK * DM; it += GSIZE) {
        const int col = it & 1023, row = it >> 10;
        x[it] = f2bf(ALPHA_F * bf2f(hb[it]) + dot_bf16(mg + (size_t)row * DM, wt + (size_t)col * DM, DM));
    }
}

__device__ __forceinline__ void ph_ln1_route(const Params& p, int l, float* hrow_all) {
    const bf16_t* x = (const bf16_t*)(p.ws + OFF_X); bf16_t* hb = (bf16_t*)(p.ws + OFF_HB);
    int* tope = (int*)(p.ws + OFF_TOPE); float* topw = (float*)(p.ws + OFF_TOPW); int* topp = (int*)(p.ws + OFF_TOPP);
    unsigned* cnt = (unsigned*)(p.ws + OFF_CNT) + l * 64; int* perm = (int*)(p.ws + OFF_PERM);
    const float* g1 = p.ln1_g + (size_t)l * DM; const float* b1 = p.ln1_b + (size_t)l * DM;
    const float* wr = p.w_router + (size_t)l * DM * NEXP; const float rb = p.router_bias[l * NEXP + (TIDX & 63)];
    const int lane = TIDX & 63, wv = TIDX >> 6, gw = GTID >> 6, nw = GSIZE >> 6;
    float* hrow = hrow_all + wv * DM;
    for (int row = gw; row < NTOK; row += nw) {
        const bf16_t* xr = x + (size_t)row * DM;
        float v[16]; float s = 0.f;
#pragma unroll
        for (int i = 0; i < 4; ++i) { const ushort4 u = *(const ushort4*)(xr + i * 256 + lane * 4); v[i * 4] = bf2f(u.x); v[i * 4 + 1] = bf2f(u.y); v[i * 4 + 2] = bf2f(u.z); v[i * 4 + 3] = bf2f(u.w);
            s += v[i * 4] + v[i * 4 + 1] + v[i * 4 + 2] + v[i * 4 + 3]; }
        const float mu = wave_sum(s) * (1.0f / DM); float q = 0.f;
#pragma unroll
        for (int i = 0; i < 16; ++i) { v[i] -= mu; q += v[i] * v[i]; }
        const float rs = rsqrtf(wave_sum(q) * (1.0f / DM) + LN_EPS);
#pragma unroll
        for (int i = 0; i < 4; ++i) { const int c = i * 256 + lane * 4;
            const float4 g = *(const float4*)(g1 + c), b = *(const float4*)(b1 + c);
            float4 o; o.x = v[i * 4] * rs * g.x + b.x; o.y = v[i * 4 + 1] * rs * g.y + b.y; o.z = v[i * 4 + 2] * rs * g.z + b.z; o.w = v[i * 4 + 3] * rs * g.w + b.w;
            *(float4*)(hrow + c) = o;
            ushort4 ob; ob.x = f2bf(o.x); ob.y = f2bf(o.y); ob.z = f2bf(o.z); ob.w = f2bf(o.w);
            *(ushort4*)(hb + (size_t)row * DM + c) = ob; }
        __builtin_amdgcn_wave_barrier();
        float lg = 0.f;
        for (int k = 0; k < DM; k += 4) { const float4 hv = *(const float4*)(hrow + k);
            lg += hv.x * wr[(size_t)k * NEXP + lane]; lg += hv.y * wr[(size_t)(k + 1) * NEXP + lane]; lg += hv.z * wr[(size_t)(k + 2) * NEXP + lane]; lg += hv.w * wr[(size_t)(k + 3) * NEXP + lane]; }
        __builtin_amdgcn_wave_barrier();
        const float score = sigmoidf_(lg), biased = score + rb;
        int rk = 0;
#pragma unroll
        for (int j = 0; j < 8; ++j) { const int src = (lane & ~7) | j; const float o = __shfl(biased, src); rk += (o > biased || (o == biased && src < lane)) ? 1 : 0; }
        float gs = (rk < 2) ? biased : 0.f;
        gs += __shfl_xor(gs, 1); gs += __shfl_xor(gs, 2); gs += __shfl_xor(gs, 4);
        int grk = 0;
#pragma unroll
        for (int j = 0; j < 8; ++j) { const float o = __shfl(gs, j * 8); const int myg = lane >> 3; grk += (o > gs || (o == gs && j < myg)) ? 1 : 0; }
        const float mval = (grk < 4) ? biased : -1e30f;
        int erk = 0;
        for (int j = 0; j < 64; ++j) { const float o = __shfl(mval, j); erk += (o > mval || (o == mval && j < lane)) ? 1 : 0; }
        const bool sel = erk < 8;
        const float wsum = wave_sum(sel ? score : 0.f);
        if (sel) {
            const float w = score / (wsum + 1e-20f) * 2.5f;
            const unsigned pos = atomicAdd(&cnt[lane], 1u);
            tope[(size_t)row * 8 + erk] = lane; topw[(size_t)row * 8 + erk] = w; topp[(size_t)row * 8 + erk] = (int)pos; perm[(size_t)lane * NTOK + pos] = row;
        }
    }
}

__device__ __forceinline__ void ph_hid_naive(const Params& p, int l, int* offs) {
    const bf16_t* hb = (const bf16_t*)(p.ws + OFF_HB); const bf16_t* gu = (const bf16_t*)(p.ws + OFF_EXPGU); bf16_t* hid = (bf16_t*)(p.ws + OFF_HID);
    const int* tope = (const int*)(p.ws + OFF_TOPE); const float* topw = (const float*)(p.ws + OFF_TOPW); const int* topp = (const int*)(p.ws + OFF_TOPP);
    const long total = (long)NTOK * 9 * EH;
    for (long it = GTID; it < total; it += GSIZE) {
        const int j = (int)(it & 255); const int slot = (int)(it >> 8); const int t = slot / 9, k = slot % 9;
        int e; float w; size_t orow;
        if (k < 8) { e = tope[t * 8 + k]; w = topw[t * 8 + k]; orow = (size_t)offs[e] + topp[t * 8 + k]; } else { e = 64; w = 1.0f; orow = (size_t)8 * NTOK + t; }
        const bf16_t* wg = gu + ((size_t)e * 512 + (j >> 7) * 256 + (j & 127)) * DM; const bf16_t* wu = wg + (size_t)128 * DM;
        const float g = dot_bf16(hb + (size_t)t * DM, wg, DM), u = dot_bf16(hb + (size_t)t * DM, wu, DM);
        (void)w; hid[orow * EH + j] = f2bf(siluf_(g) * u);
    }
}
__device__ __forceinline__ void ph_down_naive(const Params& p, int l, int* offs) {
    const bf16_t* hb = (const bf16_t*)(p.ws + OFF_HB); const bf16_t* dn = (const bf16_t*)(p.ws + OFF_EXPDN); const bf16_t* hid = (const bf16_t*)(p.ws + OFF_HID);
    bf16_t* outs = (bf16_t*)(p.ws + OFF_OUTS); bf16_t* x = (bf16_t*)(p.ws + OFF_X);
    const long total = (long)NTOK * 9 * DM;
    for (long it = GTID; it < total; it += GSIZE) {
        const int n = (int)(it & 1023); const int row = (int)(it >> 10);
        if (row < 8 * NTOK) { int e = 0;
            for (int q = 1; q < 64; ++q) e += (row >= offs[q]) ? 1 : 0;
            outs[(size_t)row * DM + n] = f2bf(dot_bf16(hid + (size_t)row * EH, dn + ((size_t)e * DM + n) * EH, EH));
        } else { const int t = row - 8 * NTOK;
            x[(size_t)t * DM + n] = f2bf(ALPHA_F * bf2f(hb[(size_t)t * DM + n]) + dot_bf16(hid + (size_t)row * EH, dn + ((size_t)64 * DM + n) * EH, EH)); }
    }
}
__device__ __forceinline__ void ph_combine_ln2(const Params& p, int l, int* offs) {
    const bf16_t* x = (const bf16_t*)(p.ws + OFF_X); const bf16_t* outs = (const bf16_t*)(p.ws + OFF_OUTS); bf16_t* hb = (bf16_t*)(p.ws + OFF_HB);
    const int* tope = (const int*)(p.ws + OFF_TOPE); const int* topp = (const int*)(p.ws + OFF_TOPP); const float* topw = (const float*)(p.ws + OFF_TOPW);
    const float* g2 = p.ln2_g + (size_t)l * DM; const float* b2 = p.ln2_b + (size_t)l * DM;
    const int lane = TIDX & 63, gw = GTID >> 6, nw = GSIZE >> 6;
    for (int row = gw; row < NTOK; row += nw) {
        float v[16];
#pragma unroll
        for (int i = 0; i < 4; ++i) { const ushort4 u = *(const ushort4*)(x + (size_t)row * DM + i * 256 + lane * 4); v[i * 4] = bf2f(u.x); v[i * 4 + 1] = bf2f(u.y); v[i * 4 + 2] = bf2f(u.z); v[i * 4 + 3] = bf2f(u.w); }
        for (int k = 0; k < 8; ++k) { const size_t r = (size_t)offs[tope[row * 8 + k]] + topp[row * 8 + k]; const float w = topw[row * 8 + k];
#pragma unroll
            for (int i = 0; i < 4; ++i) { const ushort4 u = *(const ushort4*)(outs + r * DM + i * 256 + lane * 4); v[i * 4] += w * bf2f(u.x); v[i * 4 + 1] += w * bf2f(u.y); v[i * 4 + 2] += w * bf2f(u.z); v[i * 4 + 3] += w * bf2f(u.w); } }
        float s = 0.f;
#pragma unroll
        for (int i = 0; i < 16; ++i) s += v[i];
        const float mu = wave_sum(s) * (1.0f / DM); float q = 0.f;
#pragma unroll
        for (int i = 0; i < 16; ++i) { v[i] -= mu; q += v[i] * v[i]; }
        const float rs = rsqrtf(wave_sum(q) * (1.0f / DM) + LN_EPS);
#pragma unroll
        for (int i = 0; i < 4; ++i) { const int c = i * 256 + lane * 4;
            const float4 g = *(const float4*)(g2 + c), b = *(const float4*)(b2 + c);
            float4 o; o.x = v[i * 4] * rs * g.x + b.x; o.y = v[i * 4 + 1] * rs * g.y + b.y; o.z = v[i * 4 + 2] * rs * g.z + b.z; o.w = v[i * 4 + 3] * rs * g.w + b.w;
            if (l == NLAYER - 1) *(float4*)(p.out + (size_t)row * DM + c) = o;
            else { ushort4 ob; ob.x = f2bf(o.x); ob.y = f2bf(o.y); ob.z = f2bf(o.z); ob.w = f2bf(o.w); *(ushort4*)(hb + (size_t)row * DM + c) = ob; } }
    }
}

__device__ __forceinline__ void ph_ln1_route_fast(const Params& p, int l, LAS unsigned char* lds) {
    typedef float f32x4 __attribute__((ext_vector_type(4)));
    int tid_ = TIDX; asm volatile("" : "+v"(tid_));
    const int tid = tid_, wv = __builtin_amdgcn_readfirstlane(tid >> 6), lane = tid & 63;
    const bf16_t* x = (const bf16_t*)(p.ws + OFF_X); bf16_t* hb = (bf16_t*)(p.ws + OFF_HB);
    int* tope = (int*)(p.ws + OFF_TOPE); float* topw = (float*)(p.ws + OFF_TOPW); int* topp = (int*)(p.ws + OFF_TOPP);
    unsigned* cnt = (unsigned*)(p.ws + OFF_CNT) + l * 64; int* perm = (int*)(p.ws + OFF_PERM);
    const float* g1 = p.ln1_g + (size_t)l * DM; const float* b1 = p.ln1_b + (size_t)l * DM;
    const float* wr = p.w_router + (size_t)l * DM * NEXP; const float rb = p.router_bias[l * NEXP + lane];
    constexpr int HS = 1028;
    LAS float* hrow = (LAS float*)lds;
    LAS float* lgt = (LAS float*)(lds + 32 * HS * 4);
    for (int r0 = blockIdx.x * 32; r0 < NTOK; r0 += gridDim.x * 32) {
#pragma unroll
        for (int rr = 0; rr < 4; ++rr) { const int rl = 4 * wv + rr, row = r0 + rl;
            const bf16_t* xr = x + (size_t)row * DM;
            float v[16]; float s = 0.f;
#pragma unroll
            for (int i = 0; i < 4; ++i) { const ushort4 u = *(const ushort4*)(xr + i * 256 + lane * 4); v[i * 4] = bf2f(u.x); v[i * 4 + 1] = bf2f(u.y); v[i * 4 + 2] = bf2f(u.z); v[i * 4 + 3] = bf2f(u.w);
                s += v[i * 4] + v[i * 4 + 1] + v[i * 4 + 2] + v[i * 4 + 3]; }
            const float mu = wave_sum(s) * (1.0f / DM); float q = 0.f;
#pragma unroll
            for (int i = 0; i < 16; ++i) { v[i] -= mu; q += v[i] * v[i]; }
            const float rs = rsqrtf(wave_sum(q) * (1.0f / DM) + LN_EPS);
#pragma unroll
            for (int i = 0; i < 4; ++i) { const int c = i * 256 + lane * 4;
                const float4 g = *(const float4*)(g1 + c), b = *(const float4*)(b1 + c);
                f32x4 o; o[0] = v[i * 4] * rs * g.x + b.x; o[1] = v[i * 4 + 1] * rs * g.y + b.y; o[2] = v[i * 4 + 2] * rs * g.z + b.z; o[3] = v[i * 4 + 3] * rs * g.w + b.w;
                *(LAS f32x4*)(hrow + rl * HS + c) = o;
                ushort4 ob; ob.x = f2bf(o[0]); ob.y = f2bf(o[1]); ob.z = f2bf(o[2]); ob.w = f2bf(o[3]);
                *(ushort4*)(hb + (size_t)row * DM + c) = ob; } }
        __syncthreads();
        { const int rt = wv & 1, et = wv >> 1; const int li = lane & 15, kq = lane >> 4;
          f32x4 acc = {0.f, 0.f, 0.f, 0.f};
          const LAS float* ap = hrow + (rt * 16 + li) * HS + 4 * kq;
          const float* bp = wr + (size_t)(4 * kq) * NEXP + et * 16 + li;
#pragma unroll 4
          for (int s = 0; s < 64; ++s) { const f32x4 a = *(const LAS f32x4*)(ap + 16 * s);
              const float b0 = bp[(size_t)(16 * s + 0) * NEXP], b1v = bp[(size_t)(16 * s + 1) * NEXP], b2 = bp[(size_t)(16 * s + 2) * NEXP], b3 = bp[(size_t)(16 * s + 3) * NEXP];
              acc = __builtin_amdgcn_mfma_f32_16x16x4f32(a[0], b0, acc, 0, 0, 0); acc = __builtin_amdgcn_mfma_f32_16x16x4f32(a[1], b1v, acc, 0, 0, 0);
              acc = __builtin_amdgcn_mfma_f32_16x16x4f32(a[2], b2, acc, 0, 0, 0); acc = __builtin_amdgcn_mfma_f32_16x16x4f32(a[3], b3, acc, 0, 0, 0); }
#pragma unroll
          for (int r = 0; r < 4; ++r) lgt[(rt * 16 + 4 * kq + r) * 65 + et * 16 + li] = acc[r]; }
        __syncthreads();
#pragma unroll
        for (int rr = 0; rr < 4; ++rr) { const int rl = 4 * wv + rr, row = r0 + rl;
            const float lg = lgt[rl * 65 + lane];
            const float score = sigmoidf_(lg), biased = score + rb;
            int rk = 0;
#pragma unroll
            for (int j = 0; j < 8; ++j) { const int src = (lane & ~7) | j; const float o = __shfl(biased, src); rk += (o > biased || (o == biased && src < lane)) ? 1 : 0; }
            float gs = (rk < 2) ? biased : 0.f;
            gs += __shfl_xor(gs, 1); gs += __shfl_xor(gs, 2); gs += __shfl_xor(gs, 4);
            int grk = 0;
#pragma unroll
            for (int j = 0; j < 8; ++j) { const float o = __shfl(gs, j * 8); const int myg = lane >> 3; grk += (o > gs || (o == gs && j < myg)) ? 1 : 0; }
            const float mval = (grk < 4) ? biased : -1e30f;
            int erk = 0;
#pragma unroll 8
            for (int j = 0; j < 64; ++j) { const float o = __shfl(mval, j); erk += (o > mval || (o == mval && j < lane)) ? 1 : 0; }
            const bool sel = erk < 8;
            const float wsum = wave_sum(sel ? score : 0.f);
            if (sel) { const float w = score / (wsum + 1e-20f) * 2.5f;
                const unsigned pos = atomicAdd(&cnt[lane], 1u);
                tope[(size_t)row * 8 + erk] = lane; topw[(size_t)row * 8 + erk] = w; topp[(size_t)row * 8 + erk] = (int)pos; perm[(size_t)lane * NTOK + pos] = row; } }
        __syncthreads();
    }
}

__device__ __forceinline__ void ph_inproj_fast(const Params& p, int l, LAS unsigned char* stage) {
    g8::StaticSched S; S.init(p.ws + OFF_HB, DM, p.ws + OFF_WTIG, DM, NTOK, 8704, DM, (int)gridDim.x, (int)blockIdx.x);
    g8::EpiInGate E{(bf16_t*)(p.ws + OFF_PROJ), (bf16_t*)(p.ws + OFF_GATES), p.b_gate + (size_t)l * 4096};
    g8::gemm_stream(stage, S, E);
}
__device__ __forceinline__ void ph_merge_fast(const Params& p, LAS unsigned char* stage) {
    g8::MergeSched S; S.A = (const char*)(p.ws + OFF_Y); S.B = (const char*)(p.ws + OFF_WTBR); S.lda = 1280; S.ldb = 1280; S.K = 256; S.G = (int)gridDim.x; S.c = (int)blockIdx.x;
    g8::EpiMerge E{(bf16_t*)(p.ws + OFF_MERGED), (const bf16_t*)(p.ws + OFF_GATES)};
    g8::gemm_stream(stage, S, E);
}
__device__ __forceinline__ void ph_outproj_fast(const Params& p, LAS unsigned char* stage) {
    g8::StaticSched S; S.init(p.ws + OFF_MERGED, DM, p.ws + OFF_WTOUT, DM, NTOK, DM, DM, (int)gridDim.x, (int)blockIdx.x);
    g8::EpiResid E{(bf16_t*)(p.ws + OFF_X), (const bf16_t*)(p.ws + OFF_HB)};
    g8::gemm_stream(stage, S, E);
}
__device__ __forceinline__ void ph_hid_fast(const Params& p, const LAS int* offs, const LAS int* tp, LAS unsigned char* stage) {
    g8::GroupSched<true> S; S.A = (const char*)(p.ws + OFF_HB); S.B = (const char*)(p.ws + OFF_EXPGU); S.bstride = (size_t)512 * DM * 2; S.lda = DM; S.ldb = DM; S.K = DM;
    S.offs = offs; S.tp = tp; S.perm = (const int*)(p.ws + OFF_PERM); S.NC = 2; S.G = (int)gridDim.x; S.c = (int)blockIdx.x;
    g8::EpiGateUp E{(bf16_t*)(p.ws + OFF_HID)};
    g8::gemm_stream(stage, S, E);
}
__device__ __forceinline__ void ph_down_fast(const Params& p, const LAS int* offs, const LAS int* tp, LAS unsigned char* stage) {
    g8::GroupSched<false> S; S.A = (const char*)(p.ws + OFF_HID); S.B = (const char*)(p.ws + OFF_EXPDN); S.bstride = (size_t)DM * EH * 2; S.lda = EH; S.ldb = EH; S.K = EH;
    S.offs = offs; S.tp = tp; S.perm = nullptr; S.NC = 4; S.G = (int)gridDim.x; S.c = (int)blockIdx.x;
    g8::EpiDown E{(bf16_t*)(p.ws + OFF_OUTS), (bf16_t*)(p.ws + OFF_X), (const bf16_t*)(p.ws + OFF_HB)};
    g8::gemm_stream(stage, S, E);
}

__device__ __forceinline__ void ph_attn_fast(const Params& p, int l, LAS unsigned char* stage) {
    if (FAST_MASK & 32) { for (int v = blockIdx.x; v < 256; v += gridDim.x) { const int u = (gridDim.x == 256) ? (((v & 7) * 2 + ((v >> 3) >> 4)) * 16 + ((v >> 3) & 15)) : v; att::attn_unit<1>(p, l, u, stage); } } else ph_nat_naive(p, l);
    if (FAST_MASK & 64) { for (int v = blockIdx.x; v < 256; v += gridDim.x) { const int u = (gridDim.x == 256) ? (((v & 7) * 2 + ((v >> 3) >> 4)) * 16 + ((v >> 3) & 15)) : v; att::attn_unit<0>(p, l, u, stage); } } else ph_diff_naive(p, l);
}

#define NPH 16
#define STAGE_OFF 2048
__global__ void __launch_bounds__(NTHREADS, 2) fwd_kernel(Params p) {
    extern __shared__ __attribute__((aligned(16))) unsigned char lds[];
    LAS unsigned char* ldsl = (LAS unsigned char*)lds;
    volatile LAS unsigned* xbw = (volatile LAS unsigned*)ldsl;
    LAS int* offs = (LAS int*)(ldsl + 16);
    LAS int* tp = (LAS int*)(ldsl + 512);
    LAS unsigned char* stage = ldsl + STAGE_OFF;
    unsigned char* scratch = lds + STAGE_OFF;
    if (threadIdx.x < 4) xbw[threadIdx.x] = 0u;
    if ((threadIdx.x & 63) == 0) ((volatile LAS int*)(ldsl + WIDTAB_OFF))[(unsigned)__builtin_amdgcn_s_getreg((5 << 11) | 4) & 63u] = (int)(threadIdx.x >> 6);
    __syncthreads();
    XcdBarrier bar = xcd_barrier_post((unsigned*)(p.ws + OFF_BAR), xbw);
    const int lo = p.ph_lo, hi = p.ph_hi;
#define IN(k) (lo <= (k) && (k) < hi)
#define SEAM(k) do { if (IN(k) && IN((k) + 1)) xcd_barrier(bar); } while (0)
#define RUNPH(k, body) if (IN(pb + (k))) { body; if (REPEAT_PH == (k)) { xcd_barrier(bar); body; } }
#define LAYER_BODY(l) do { \
        const int pb = l * NPH; \
        RUNPH(0, { ph_conv_mixer_weights(p, l, (bf16_t*)scratch); if (l == 0) ph_ln_in(p); }) \
        SEAM(pb + 0); \
        RUNPH(1, { if (FAST_MASK & 1) ph_inproj_fast(p, l, stage); else ph_inproj_naive(p, l); }) \
        SEAM(pb + 1); \
        if (REPEAT_PH == 99) { for (int q_ = 0; q_ < 8; ++q_) xcd_barrier(bar); } \
        RUNPH(2, { if (FAST_MASK & 128) { for (int u = blockIdx.x; u < 2048; u += gridDim.x) rec::phase_a_unit(p, l, u, stage); } else ph_recur_naive(p, l); }) \
        SEAM(pb + 2); \
        RUNPH(10, { if (FAST_MASK & 128) rec::phase_b(p); ph_attn_fast(p, l, stage); }) \
        if (IN(pb + 10) && IN(pb + 3)) xcd_barrier(bar); \
        RUNPH(3, { if (FAST_MASK & 128) { for (int u = blockIdx.x; u < 2048; u += gridDim.x) rec::phase_c_unit(p, l, u, stage); } else ph_recur_finish(p, l); if (!(FAST_MASK & 64)) ph_diff_finish(p, l); }) \
        SEAM(pb + 3); \
        RUNPH(4, { if (FAST_MASK & 2) ph_merge_fast(p, stage); else ph_merge_naive(p); }) \
        SEAM(pb + 4); \
        RUNPH(5, { if (FAST_MASK & 4) ph_outproj_fast(p, stage); else ph_outproj_naive(p); __syncthreads(); ph_conv_expert_weights(p, l, (bf16_t*)scratch); }) \
        SEAM(pb + 5); \
        if (IN(pb + 6)) { if (FAST_MASK & 256) ph_ln1_route_fast(p, l, stage); else ph_ln1_route(p, l, (float*)scratch); } \
        SEAM(pb + 6); \
        if (IN(pb + 7) || IN(pb + 8) || IN(pb + 9)) { \
            __syncthreads(); \
            if (TIDX == 0) { const unsigned* cnt = (const unsigned*)(p.ws + OFF_CNT) + l * 64; int a = 0, t = 0; \
                for (int e = 0; e < 64; ++e) { offs[e] = a; tp[e] = t; const int c = (int)cnt[e]; a += c; t += (c + 255) >> 8; } \
                offs[64] = a; tp[64] = t; offs[65] = a + NTOK; tp[65] = t + NTOK / 256; } \
            __syncthreads(); \
        } \
        RUNPH(7, { if (FAST_MASK & 8) ph_hid_fast(p, offs, tp, stage); else ph_hid_naive(p, l, (int*)(lds + 16)); }) \
        SEAM(pb + 7); \
        RUNPH(8, { if (FAST_MASK & 16) ph_down_fast(p, offs, tp, stage); else ph_down_naive(p, l, (int*)(lds + 16)); }) \
        SEAM(pb + 8); \
        RUNPH(9, { ph_combine_ln2(p, l, (int*)(lds + 16)); }) \
        SEAM(pb + 9); \
    } while (0)
    LAYER_BODY(0);
    LAYER_BODY(1);
#undef IN
#undef SEAM
}

#define LDS_BYTES (STAGE_OFF + 144 * 1024)

extern "C" void kernel_launch(void* const* d_in, const int* in_sizes, int n_in, void* d_out, int out_size, void* d_ws, size_t ws_size, hipStream_t stream) {
    static int grid = 0;
    if (grid == 0) {
        if (n_in != 29 || out_size != NTOK * DM || ws_size < WS_END) { fprintf(stderr, "kernel_launch: unexpected shapes (n_in %d out %d ws %zu need %zu)\n", n_in, out_size, ws_size, (size_t)WS_END); grid = -1; return; }
        int dev = 0, cus = 0, per_cu = 0;
        if (hipGetDevice(&dev) != hipSuccess || hipDeviceGetAttribute(&cus, hipDeviceAttributeMultiprocessorCount, dev) != hipSuccess) { grid = -1; return; }
        if (hipFuncSetAttribute((const void*)fwd_kernel, hipFuncAttributeMaxDynamicSharedMemorySize, LDS_BYTES) != hipSuccess) { grid = -1; return; }
        if (hipOccupancyMaxActiveBlocksPerMultiprocessor(&per_cu, (const void*)fwd_kernel, NTHREADS, LDS_BYTES) != hipSuccess || per_cu < 1) { fprintf(stderr, "occupancy query: %d\n", per_cu); }
        (void)hipGetLastError();
        grid = cus;
    }
    if (grid < 0) return;
    hipMemsetAsync((char*)d_ws, 0, CTL_ZERO_BYTES, stream);
    Params p{};
    const float** pp = (const float**)&p;
    for (int i = 0; i < 29; ++i) pp[i] = (const float*)d_in[i];
    p.out = (float*)d_out; p.ws = (unsigned char*)d_ws; p.ph_lo = 0; p.ph_hi = NLAYER * NPH;
    hipLaunchKernelGGL(fwd_kernel, dim3(grid), dim3(NTHREADS), LDS_BYTES, stream, p);
}

#ifdef TEST_PHASE
__global__ void __launch_bounds__(NTHREADS, 2) test_kernel(Params p) {
    extern __shared__ __attribute__((aligned(16))) unsigned char lds[];
    LAS unsigned char* ldsl = (LAS unsigned char*)lds;
    LAS int* offs = (LAS int*)(ldsl + 16); LAS int* tp = (LAS int*)(ldsl + 512);
    LAS unsigned char* stage = ldsl + STAGE_OFF;
#if TEST_PHASE == 1
    ph_inproj_fast(p, 1, stage);
#elif TEST_PHASE == 2
    ph_merge_fast(p, stage);
#elif TEST_PHASE == 3
    ph_outproj_fast(p, stage);
#elif TEST_PHASE == 4
    ph_hid_fast(p, offs, tp, stage);
#elif TEST_PHASE == 5
    ph_down_fast(p, offs, tp, stage);
#elif TEST_PHASE == 6
    att::attn_unit<0>(p, 1, blockIdx.x, stage);
#elif TEST_PHASE == 7
    att::attn_unit<1>(p, 1, blockIdx.x, stage);
#elif TEST_PHASE == 8
    rec::phase_c_unit(p, 1, blockIdx.x, stage);
#elif TEST_PHASE == 9
    rec::phase_a_unit(p, 1, blockIdx.x, stage);
#elif TEST_PHASE == 10
    ph_ln1_route_fast(p, 1, stage);
#endif
}
#endif
```

```cpp
#include <hip/hip_runtime.h>
#include <stdint.h>
#include <stdio.h>
#ifndef REPEAT_PH
#define REPEAT_PH -1
#endif
#ifndef FAST_MASK
#define FAST_MASK 0x1ff
#endif

typedef unsigned short bf16_t;
typedef unsigned int u32;

#define NTOK 16384
#define SEQ 4096
#define DM 1024
#define INW 4608
#define NLAYER 2
#define NEXP 64
#define EH 256
#define ALPHA_F 1.41421356237309515f
#define LN_EPS 1e-5f
#define NTHREADS 512

#define MIB ((size_t)1 << 20)
#define OFF_BAR   ((size_t)0)
#define OFF_CNT   ((size_t)16384)
#define CTL_ZERO_BYTES ((size_t)32768)
#define OFF_WTIG  (1 * MIB)
#define OFF_WTBR  (18 * MIB)
#define OFF_WTOUT (OFF_WTBR + 2560 * 1024)
#define OFF_HB    (23 * MIB)
#define OFF_X     (55 * MIB)
#define OFF_EXPW  (87 * MIB)
#define OFF_EXPGU OFF_EXPW
#define OFF_EXPDN (OFF_EXPW + 65 * MIB)
#define OFF_OTMP  OFF_EXPW
#define OFF_ROUTE (185 * MIB)
#define OFF_TOPE  OFF_ROUTE
#define OFF_TOPW  (OFF_ROUTE + 512 * 1024)
#define OFF_TOPP  (OFF_ROUTE + 1024 * 1024)
#define OFF_PERM  (OFF_ROUTE + 1536 * 1024)
#define OFF_R     (191 * MIB)
#define OFF_PROJ  OFF_R
#define OFF_GATES (OFF_R + 144 * MIB)
#define OFF_Y     (OFF_R + 272 * MIB)
#define OFF_MERGED OFF_R
#define OFF_HID   OFF_R
#define OFF_OUTS  (OFF_R + 72 * MIB)
#define OFF_DTMP  OFF_X
#define OFF_HB8   (OFF_R + 329 * MIB)
#define OFF_W8    (OFF_WTIG + (size_t)4608 * 2048)
#define WS_END    (OFF_R + 345 * MIB)

struct Params {
    const float* x; const float* ln_in_g; const float* ln_in_b; const float* w_in; const float* w_gate; const float* b_gate;
    const float* w_br_ret; const float* w_br_nat; const float* w_br_hgrn; const float* w_br_diff; const float* w_out;
    const float* ret_gn; const float* nat_rpb; const float* hgrn_lb; const float* hgrn_gn; const float* diff_lambda; const float* diff_subln;
    const float* ln1_g; const float* ln1_b; const float* w_router; const float* router_bias;
    const float* w_e_gate; const float* w_e_up; const float* w_e_down; const float* w_s_gate; const float* w_s_up; const float* w_s_down;
    const float* ln2_g; const float* ln2_b;
    float* out; unsigned char* ws;
    int ph_lo, ph_hi;
};


#define WIDTAB_OFF 1024
#ifndef LAS
#define LAS __attribute__((address_space(3)))
#endif
__device__ __forceinline__ int tidx_() {
    extern __shared__ __attribute__((aligned(16))) unsigned char lds_any_[];
    const unsigned hw = (unsigned)__builtin_amdgcn_s_getreg((5 << 11) | 4) & 63u;
    const int wid = ((volatile LAS int*)((LAS unsigned char*)lds_any_ + WIDTAB_OFF))[hw];
    int lane; asm volatile("v_mbcnt_lo_u32_b32 %0, -1, 0\n\tv_mbcnt_hi_u32_b32 %0, -1, %0" : "=v"(lane));
    return __builtin_amdgcn_readfirstlane(wid) * 64 + lane;
}
#define TIDX tidx_()

#define XB_TMO      128
#define XB_XCNT(j)  (256  + 64 * (j))
#define XB_XSUB(j)  (1280 + 64 * (j))
#define XB_XGEN(j)  (2304 + 64 * (j))
#define XB_TOP      3328
#define XB_TOPGEN   3392
#define XCD_BAR_WORDS 3456
#define XB_SPIN_CAP (1u << 27)
#define LAS __attribute__((address_space(3)))

__device__ __forceinline__ unsigned xb_ld(unsigned* p)              { return __hip_atomic_load(p, __ATOMIC_RELAXED, __HIP_MEMORY_SCOPE_AGENT); }
__device__ __forceinline__ unsigned xb_add(unsigned* p, unsigned v) { return __hip_atomic_fetch_add(p, v, __ATOMIC_RELAXED, __HIP_MEMORY_SCOPE_AGENT); }
__device__ __forceinline__ unsigned xb_xcc_id() { return (unsigned)__builtin_amdgcn_s_getreg((3 << 11) | 20) & 0xFu; }
#define XB_SPIN(cond, bar) do { unsigned _sp = 0; while (cond) { __builtin_amdgcn_s_sleep(1); \
    if ((++_sp & 255u) == 0u) { if (xb_ld(&(bar)[XB_TMO])) break; if (_sp > XB_SPIN_CAP) { atomicAdd(&(bar)[XB_TMO], 1u); break; } } } } while (0)

struct XcdBarrier { unsigned* bar; unsigned x; volatile LAS unsigned* st; };

__device__ __forceinline__ XcdBarrier xcd_barrier_post(unsigned* bar, volatile LAS unsigned* st) {
    XcdBarrier b; b.bar = bar; b.x = xb_xcc_id(); b.st = st;
    if (TIDX == 0) (void)xb_add(&bar[XB_XCNT(b.x)], 1u);
    return b;
}
__device__ __forceinline__ void xcd_barrier_complete(unsigned* bar, unsigned x, unsigned& nloc, unsigned& nx) {
    const unsigned G = gridDim.x * gridDim.y * gridDim.z;
    unsigned sum, cnt, mine, sp = 0u;
    for (;;) {
        sum = 0u; cnt = 0u; mine = 0u;
#pragma unroll
        for (unsigned j = 0; j < 16; ++j) { const unsigned c = xb_ld(&bar[XB_XCNT(j)]); sum += c; cnt += (c > 0u) ? 1u : 0u; mine = (j == x) ? c : mine; }
        if (sum == G) break;
        __builtin_amdgcn_s_sleep(1);
        if ((++sp & 255u) == 0u) { if (xb_ld(&bar[XB_TMO])) break; if (sp > XB_SPIN_CAP) { atomicAdd(&bar[XB_TMO], 1u); break; } }
    }
    nloc = mine > 0u ? mine : 1u; nx = cnt > 0u ? cnt : 1u;
}
__device__ __forceinline__ void xcd_barrier(const XcdBarrier& b) {
    asm volatile("s_waitcnt vmcnt(0)" ::: "memory");
    __syncthreads();
    if (TIDX == 0) {
        unsigned* bar = b.bar;
        __builtin_amdgcn_s_waitcnt(0);
        unsigned nloc = b.st[0], nx = b.st[1];
        if (nloc == 0u) { xcd_barrier_complete(bar, b.x, nloc, nx); b.st[0] = nloc; b.st[1] = nx; }
        const unsigned old = xb_add(&bar[XB_XSUB(b.x)], 1u);
        const unsigned gen = old / nloc;
        if (old + 1u == (gen + 1u) * nloc) {
            __builtin_amdgcn_fence(__ATOMIC_RELEASE, "agent");
            asm volatile("s_waitcnt vmcnt(0)" ::: "memory");
            const unsigned og = xb_add(&bar[XB_TOP], 1u);
            const unsigned tg = og / nx;
            if (og + 1u == (tg + 1u) * nx) xb_add(&bar[XB_TOPGEN], 1u);
            else XB_SPIN(xb_ld(&bar[XB_TOPGEN]) == tg, bar);
            __builtin_amdgcn_fence(__ATOMIC_ACQUIRE, "agent");
            xb_add(&bar[XB_XGEN(b.x)], 1u);
            asm volatile("s_waitcnt vmcnt(0)" ::: "memory");
        } else {
            XB_SPIN(xb_ld(&bar[XB_XGEN(b.x)]) == gen, bar);
            __builtin_amdgcn_fence(__ATOMIC_ACQUIRE, "agent");
            asm volatile("s_waitcnt vmcnt(0)" ::: "memory");
        }
    }
    __syncthreads();
}

__device__ __forceinline__ float bf2f(bf16_t b) { return __uint_as_float(((unsigned)b) << 16); }
__device__ __forceinline__ bf16_t f2bf(float f) { unsigned u = __float_as_uint(f); u += 0x7FFFu + ((u >> 16) & 1u); return (bf16_t)(u >> 16); }
__device__ __forceinline__ float lo_bf(unsigned w) { return __uint_as_float(w << 16); }
__device__ __forceinline__ float hi_bf(unsigned w) { return __uint_as_float(w & 0xFFFF0000u); }
__device__ __forceinline__ float sigmoidf_(float v) { return 1.0f / (1.0f + __expf(-v)); }
__device__ __forceinline__ float siluf_(float v) { return v / (1.0f + __expf(-v)); }
__device__ __forceinline__ float wave_sum(float v) {
#pragma unroll
    for (int o = 32; o > 0; o >>= 1) v += __shfl_xor(v, o);
    return v;
}
__device__ __forceinline__ float dot_bf16(const bf16_t* a, const bf16_t* b, int K) {
    float s = 0.f;
    for (int k = 0; k < K; k += 8) {
        const uint4 va = *(const uint4*)(a + k), vb = *(const uint4*)(b + k);
        s += lo_bf(va.x) * lo_bf(vb.x) + hi_bf(va.x) * hi_bf(vb.x) + lo_bf(va.y) * lo_bf(vb.y) + hi_bf(va.y) * hi_bf(vb.y)
           + lo_bf(va.z) * lo_bf(vb.z) + hi_bf(va.z) * hi_bf(vb.z) + lo_bf(va.w) * lo_bf(vb.w) + hi_bf(va.w) * hi_bf(vb.w);
    }
    return s;
}

#define GTID ((int)(blockIdx.x * NTHREADS + TIDX))
#define GSIZE ((int)(gridDim.x * NTHREADS))

__device__ __forceinline__ void tconv_tile(const float* src, int lds_, int sk0, int sc0, bf16_t* dst, int ldd, int dn0, int dk0, bf16_t* tile) {
    const int t = TIDX;
#pragma unroll
    for (int i = 0; i < 2; ++i) {
        const int row = (t >> 4) + 32 * i, c4 = (t & 15) * 4;
        const float4 v = *(const float4*)(src + (size_t)(sk0 + row) * lds_ + sc0 + c4);
        tile[(c4 + 0) * 72 + row] = f2bf(v.x); tile[(c4 + 1) * 72 + row] = f2bf(v.y); tile[(c4 + 2) * 72 + row] = f2bf(v.z); tile[(c4 + 3) * 72 + row] = f2bf(v.w);
    }
    __syncthreads();
    { const int n = t >> 3, ch = t & 7;
      const uint4 w = *(const uint4*)&tile[n * 72 + ch * 8];
      *(uint4*)(dst + (size_t)(dn0 + n) * ldd + dk0 + ch * 8) = w; }
    __syncthreads();
}


namespace g8 {
typedef short bf16x8 __attribute__((ext_vector_type(8)));
typedef float f32x4 __attribute__((ext_vector_type(4)));
typedef unsigned u32x4 __attribute__((ext_vector_type(4)));
typedef int v8i __attribute__((ext_vector_type(8)));
typedef int v4i __attribute__((ext_vector_type(4)));
constexpr int BM = 256, BK = 64, HALF = 128, HTB = HALF * BK * 2, STAGE_BYTES = 8 * HTB, NXCD = 8, WGM = 8;
__device__ __forceinline__ int lds_byte(int r, int c) { const int st = (r >> 4) * 2 + (c >> 5), rr = r & 15, cc = c & 31, ob = rr * 64 + cc * 2; return st * 1024 + (ob ^ (((ob >> 9) & 1) << 5)); }
__device__ __forceinline__ void stage_rc(int b, int& R, int& C) { const int st = b / 1024, sb = b % 1024, swz = sb ^ (((sb >> 9) & 1) << 5); R = (st >> 1) * 16 + swz / 64; C = (st & 1) * 32 + (swz % 64) / 2; }
__device__ __forceinline__ int perm32(int rho) { const int n = rho >> 4, i = rho & 15; return 8 * (i >> 2) + 4 * n + (i & 3); }
__device__ __forceinline__ unsigned cvt_pk_bf16(float lo, float hi) { unsigned r; asm volatile("v_cvt_pk_bf16_f32 %0, %1, %2" : "=v"(r) : "v"(lo), "v"(hi)); return r; }

struct Unit { const char* A; const char* B; int row0, col0, nvalid, e, loc0, nt; };

struct StaticSched {
    static constexpr bool GATHER = false;
    const char* A; const char* B; int lda, ldb, K; int nM, nN, nwg, G, c;
    __device__ void init(const void* A_, int lda_, const void* B_, int ldb_, int M, int N, int K_, int G_, int c_) { A = (const char*)A_; B = (const char*)B_; lda = lda_; ldb = ldb_; K = K_; nM = M / BM; nN = N / BM; nwg = nM * nN; G = G_; c = c_; }
    __device__ __forceinline__ bool next(int i, Unit& u) const {
        const long L = (long)i * G + c; if (L >= nwg) return false;
        int wgid = (int)L; { const int q = nwg / NXCD, r = nwg % NXCD, xcd = wgid % NXCD, off = wgid / NXCD; wgid = (xcd < r ? xcd * (q + 1) : r * (q + 1) + (xcd - r) * q) + off; }
        const int nig = WGM * nN, gid = wgid / nig, fm = gid * WGM, gsz = (nM - fm) < WGM ? (nM - fm) : WGM;
        const int pm = fm + ((wgid % nig) % gsz), pn = (wgid % nig) / gsz;
        u.row0 = pm * BM; u.col0 = pn * BM; u.nvalid = BM; u.e = 0; u.loc0 = 0; u.nt = K / BK;
        u.A = A + (size_t)u.row0 * lda * 2; u.B = B + (size_t)u.col0 * ldb * 2; return true;
    }
    __device__ __forceinline__ void gather(const Unit&, int, int, unsigned&, unsigned&) const {}
};

struct MergeSched {
    static constexpr bool GATHER = false;
    const char* A; const char* B; int lda, ldb, K; int G, c;
    __device__ __forceinline__ bool next(int i, Unit& u) const {
        const int tile = c + (i >> 2) * G, b = i & 3; if (tile >= 256) return false;
        int wgid = tile; { const int xcd = wgid % NXCD, off = wgid / NXCD; wgid = xcd * 32 + off; }
        const int nN = 4, nig = WGM * nN, gid = wgid / nig, fm = gid * WGM;
        const int pm = fm + ((wgid % nig) % WGM), pn = (wgid % nig) / WGM;
        u.row0 = pm * BM; u.col0 = pn * BM; u.nvalid = BM; u.e = b; u.loc0 = 0; u.nt = (b == 3) ? 8 : 4;
        u.A = A + (size_t)u.row0 * lda * 2 + b * 512; u.B = B + (size_t)u.col0 * ldb * 2 + b * 512; return true;
    }
    __device__ __forceinline__ void gather(const Unit&, int, int, unsigned&, unsigned&) const {}
};
template <bool GATHER_> struct GroupSched {
    static constexpr bool GATHER = GATHER_;
    const char* A; const char* B; size_t bstride; int lda, ldb, K; const LAS int* offs; const LAS int* tp; const int* perm; int NC, G, c;
    __device__ __forceinline__ bool next(int i, Unit& u) const {
        const int L = i * G + c; const int total = tp[65] * NC; if (L >= total) return false;
        const int tl = L / NC, ct = L - tl * NC; const int lane = TIDX & 63;
        int e = (int)__builtin_popcountll(__ballot(tp[lane] <= tl)) - 1; if (tl >= tp[64]) e = 64;
        e = __builtin_amdgcn_readfirstlane(e);
        const int rt = tl - tp[e], cnt = offs[e + 1] - offs[e];
        u.e = e; u.nt = K / BK; u.loc0 = rt * BM; u.row0 = offs[e] + rt * BM; u.nvalid = (cnt - rt * BM) < BM ? (cnt - rt * BM) : BM; u.col0 = ct * BM;
        u.B = B + (size_t)e * bstride + (size_t)u.col0 * ldb * 2;
        u.A = GATHER ? A : A + (size_t)u.row0 * lda * 2; return true;
    }
    __device__ __forceinline__ void gather(const Unit& u, int R, int C, unsigned& o0, unsigned& o1) const {
        const int r0 = R < u.nvalid ? R : 0, r1 = (128 + R) < u.nvalid ? (128 + R) : 0;
        const int p0 = u.loc0 + r0, p1 = u.loc0 + r1;
        const int t0 = (u.e < 64) ? perm[u.e * NTOK + p0] : p0, t1 = (u.e < 64) ? perm[u.e * NTOK + p1] : p1;
        o0 = (unsigned)(t0 * lda + C) * 2u; o1 = (unsigned)(t1 * lda + C) * 2u;
    }
};

template <class Epi, class Sched, bool FP8 = false>
__device__ __forceinline__ void gemm_stream(LAS unsigned char* lds, const Sched& S, const Epi& E) {
    int tid_ = TIDX; asm volatile("" : "+v"(tid_));
    const int tid = tid_, wid = __builtin_amdgcn_readfirstlane(tid >> 6), lane = tid & 63, wr = wid >> 2, wc = wid & 3, fr = lane & 15, fq = lane >> 4;
    const int lda = S.lda, ldb = S.ldb;
    unsigned voffA0[2], voffA1_[2], voffB[2]; int RR[2], CC[2];
#pragma unroll
    for (int i = 0; i < 2; ++i) { int R, C; stage_rc(tid * 16 + i * 8192, R, C); const int Rb = Epi::PERM ? ((R & ~31) + perm32(R & 31)) : R; RR[i] = R; CC[i] = C;
        voffA0[i] = (unsigned)(R * lda + C) * 2u; voffA1_[i] = voffA0[i]; voffB[i] = (unsigned)(Rb * ldb + C) * 2u; }
    const size_t kstep = (size_t)(BK * 2);
    const size_t hstepB = (size_t)HALF * ldb * 2;
    const size_t hstepA = Sched::GATHER ? (size_t)0 : (size_t)HALF * lda * 2;
    const unsigned ldsw = (unsigned)wid * 1024u;
    const int aoff = lds_byte(wr * 64 + fr, fq * 8), boff = lds_byte(wc * 32 + fr, fq * 8);
#define G8_SA(b, h) (((b) * 2 + (h)) * HTB)
#define G8_SB(b, h) ((4 + (b) * 2 + (h)) * HTB)
#define G8_STAGE(bufoff, gbase, voff) do { _Pragma("unroll") for (int _i = 0; _i < 2; ++_i) \
        __builtin_amdgcn_global_load_lds((const unsigned*)((const char*)(gbase) + (voff)[_i]), (LAS unsigned*)(lds + (bufoff) + ldsw + _i * 8192), 16, 0, 0); } while (0)
#define G8_LDA(dst, b, h) do { _Pragma("unroll") for (int m = 0; m < 4; ++m) _Pragma("unroll") for (int k = 0; k < 2; ++k) dst[m].fr2[k] = *(const LAS bf16x8*)(lds + G8_SA(b, h) + aoff + m * 2048 + k * 1024); } while (0)
#define G8_LDB(dst, b, h) do { _Pragma("unroll") for (int n = 0; n < 2; ++n) _Pragma("unroll") for (int k = 0; k < 2; ++k) dst[n].fr2[k] = *(const LAS bf16x8*)(lds + G8_SB(b, h) + boff + n * 2048 + k * 1024); } while (0)
#define G8_MMA(ai, bj, At, Bt) do { __builtin_amdgcn_s_setprio(1); _Pragma("unroll") for (int m = 0; m < 4; ++m) _Pragma("unroll") for (int n = 0; n < 2; ++n) { \
        if (!FP8) { _Pragma("unroll") for (int k = 0; k < 2; ++k) acc[ai][bj][m][n] = __builtin_amdgcn_mfma_f32_16x16x32_bf16(Bt[n].fr2[k], At[m].fr2[k], acc[ai][bj][m][n], 0, 0, 0); } \
        else   \
               { const v8i b8_ = G8_CAT(Bt[n]), a8_ = G8_CAT(At[m]); asm volatile("v_mfma_scale_f32_16x16x128_f8f6f4 %0, %1, %2, %0, %3, %3 op_sel_hi:[0,0,0]" : "+v"(acc[ai][bj][m][n]) : "v"(b8_), "v"(a8_), "v"(0x7F7F7F7F)); } } \
        __builtin_amdgcn_s_setprio(0); } while (0)
#define voffA1 (*(Sched::GATHER ? &voffA1_ : &voffA0))
#define G8_CAT(f) __builtin_shufflevector((v4i)(f).fr2[0], (v4i)(f).fr2[1], 0, 1, 2, 3, 4, 5, 6, 7)
#define G8_WAIT_V(n) asm volatile("s_waitcnt vmcnt(" #n ")" ::: "memory")
#define G8_WAIT_L(n) asm volatile("s_waitcnt lgkmcnt(" #n ")" ::: "memory")
#define G8_BAR __builtin_amdgcn_s_barrier()
#define G8_SCHED __builtin_amdgcn_sched_barrier(0)
    Unit cur, nxt; int ui = 0;
    if (!S.next(0, cur)) return;
    if (Sched::GATHER) {
#pragma unroll
        for (int i = 0; i < 2; ++i) S.gather(cur, RR[i], CC[i], voffA0[i], voffA1[i]);
    }
    f32x4 acc[2][2][4][2];
#pragma unroll
    for (int a = 0; a < 2; ++a)
#pragma unroll
        for (int b = 0; b < 2; ++b)
#pragma unroll
            for (int m = 0; m < 4; ++m)
#pragma unroll
                for (int n = 0; n < 2; ++n) acc[a][b][m][n] = (f32x4){0.f, 0.f, 0.f, 0.f};
    struct Frag2 { bf16x8 fr2[2]; };
    Frag2 At[4], B0[2], B1[2];
    const char* cA = cur.A; const char* cB = cur.B;
    G8_STAGE(G8_SB(0, 0), cB, voffB); G8_STAGE(G8_SA(0, 0), cA, voffA0); G8_STAGE(G8_SB(0, 1), cB + hstepB, voffB); G8_STAGE(G8_SA(0, 1), (cA) + hstepA, voffA1);
    if (wr == 1) G8_BAR;
    G8_WAIT_V(4); G8_BAR;
    G8_STAGE(G8_SB(1, 0), cB + kstep, voffB); G8_STAGE(G8_SA(1, 0), cA + kstep, voffA0); G8_STAGE(G8_SB(1, 1), cB + hstepB + kstep, voffB);
    G8_WAIT_V(6); G8_BAR;
    for (;;) {
        const bool has_next = S.next(ui + 1, nxt);
        const char* nA = has_next ? nxt.A : cA; const char* nB = has_next ? nxt.B : cB;
        unsigned nvA0[2], nvA1[2];
        if (Sched::GATHER) {
#pragma unroll
            for (int i = 0; i < 2; ++i) { nvA0[i] = voffA0[i]; nvA1[i] = voffA1[i]; if (has_next) S.gather(nxt, RR[i], CC[i], nvA0[i], nvA1[i]); }
        }
        const int nt = cur.nt;
        for (int t = 0; t < nt; t += 2) {
            const bool last = (t == nt - 2);
            const char* a1 = cA + (size_t)(t + 1) * kstep;
            const char* a2 = last ? nA : cA + (size_t)(t + 2) * kstep; const char* b2 = last ? nB : cB + (size_t)(t + 2) * kstep;
            const char* a3 = a2 + kstep; const char* b3 = b2 + kstep;
            G8_LDB(B0, 0, 0); G8_SCHED; G8_LDA(At, 0, 0); G8_STAGE(G8_SA(1, 1), (a1) + hstepA, voffA1);
            if (Sched::GATHER) { if (last) {
#pragma unroll
                for (int i = 0; i < 2; ++i) { voffA0[i] = nvA0[i]; voffA1[i] = nvA1[i]; } } }
            G8_WAIT_L(8); G8_BAR; G8_WAIT_L(0); G8_MMA(0, 0, At, B0); G8_BAR; G8_SCHED;
            G8_LDB(B1, 0, 1); G8_STAGE(G8_SB(0, 0), b2, voffB);
            G8_BAR; G8_WAIT_L(0); G8_MMA(0, 1, At, B1); G8_BAR;
            G8_LDA(At, 0, 1); G8_STAGE(G8_SA(0, 0), a2, voffA0);
            G8_BAR; G8_WAIT_L(0); G8_MMA(1, 0, At, B0); G8_BAR; G8_SCHED;
            G8_STAGE(G8_SB(0, 1), b2 + hstepB, voffB);
            G8_WAIT_V(6); G8_BAR; G8_MMA(1, 1, At, B1); G8_BAR;
            G8_LDB(B0, 1, 0); G8_SCHED; G8_LDA(At, 1, 0); G8_STAGE(G8_SA(0, 1), (a2) + hstepA, voffA1);
            G8_WAIT_L(8); G8_BAR; G8_WAIT_L(0); G8_MMA(0, 0, At, B0); G8_BAR; G8_SCHED;
            G8_LDB(B1, 1, 1); G8_STAGE(G8_SB(1, 0), b3, voffB);
            G8_BAR; G8_WAIT_L(0); G8_MMA(0, 1, At, B1); G8_BAR;
            G8_LDA(At, 1, 1); G8_STAGE(G8_SA(1, 0), a3, voffA0);
            G8_BAR; G8_WAIT_L(0); G8_MMA(1, 0, At, B0); G8_BAR; G8_SCHED;
            G8_STAGE(G8_SB(1, 1), b3 + hstepB, voffB);
            G8_WAIT_V(6); G8_BAR; G8_MMA(1, 1, At, B1); G8_BAR;
        }
        if (FP8) asm volatile("s_nop 15\n\ts_nop 15\n\ts_nop 15" ::: "memory");
        E(acc, cur, wr, wc, fr, fq);
        if (!has_next) break;
#pragma unroll
        for (int a = 0; a < 2; ++a)
#pragma unroll
            for (int b = 0; b < 2; ++b)
#pragma unroll
                for (int m = 0; m < 4; ++m)
#pragma unroll
                    for (int n = 0; n < 2; ++n) acc[a][b][m][n] = (f32x4){0.f, 0.f, 0.f, 0.f};
        cur = nxt; cA = nA; cB = nB; ++ui;
    }
    G8_WAIT_V(0);
    if (wr == 0) G8_BAR;
    G8_BAR;
#undef G8_SA
#undef G8_SB
#undef G8_STAGE
#undef G8_LDA
#undef G8_LDB
#undef G8_MMA
#undef voffA1
#undef G8_WAIT_V
#undef G8_WAIT_L
#undef G8_BAR
#undef G8_SCHED
}

__device__ __forceinline__ u32x4 pack8(const f32x4& v0, const f32x4& v1) { u32x4 w; w.x = cvt_pk_bf16(v0[0], v0[1]); w.y = cvt_pk_bf16(v0[2], v0[3]); w.z = cvt_pk_bf16(v1[0], v1[1]); w.w = cvt_pk_bf16(v1[2], v1[3]); return w; }
__device__ __forceinline__ void unpack8(const u32x4& w, f32x4& v0, f32x4& v1) { v0[0] = lo_bf(w.x); v0[1] = hi_bf(w.x); v0[2] = lo_bf(w.y); v0[3] = hi_bf(w.y); v1[0] = lo_bf(w.z); v1[1] = hi_bf(w.z); v1[2] = lo_bf(w.w); v1[3] = hi_bf(w.w); }
__device__ __forceinline__ f32x4 sig4(const f32x4& v) { f32x4 r; for (int j = 0; j < 4; ++j) r[j] = __builtin_amdgcn_rcpf(1.0f + __expf(-v[j])); return r; }

struct EpiProj {
    static constexpr bool PERM = true;
    bf16_t* proj;
    __device__ __forceinline__ void operator()(const f32x4 (&acc)[2][2][4][2], const Unit& u, int wr, int wc, int fr_, int fq_) const {
        int fr = fr_, fq = fq_; asm volatile("" : "+v"(fr), "+v"(fq));
        const int row0 = u.row0 + wr * 64 + fr, col0 = u.col0 + wc * 32 + 8 * fq;
#pragma unroll
        for (int ai = 0; ai < 2; ++ai)
#pragma unroll
            for (int m = 0; m < 4; ++m) { bf16_t* rowp = proj + (size_t)(row0 + ai * HALF + m * 16) * INW + col0;
#pragma unroll
                for (int bj = 0; bj < 2; ++bj) *(u32x4*)(rowp + bj * HALF) = pack8(acc[ai][bj][m][0], acc[ai][bj][m][1]); }
    }
};
struct EpiGate8 {
    static constexpr bool PERM = true;
    bf16_t* gates; const float* bias;
    __device__ __forceinline__ void operator()(const f32x4 (&acc)[2][2][4][2], const Unit& u, int wr, int wc, int fr_, int fq_) const {
        int fr = fr_, fq = fq_; asm volatile("" : "+v"(fr), "+v"(fq));
        const int row0 = u.row0 + wr * 64 + fr, col0 = u.col0 + wc * 32 + 8 * fq;
        f32x4 bv[2][2];
#pragma unroll
        for (int bj = 0; bj < 2; ++bj)
#pragma unroll
            for (int n = 0; n < 2; ++n) bv[bj][n] = *(const f32x4*)(bias + col0 + bj * HALF + 4 * n);
#pragma unroll
        for (int ai = 0; ai < 2; ++ai)
#pragma unroll
            for (int m = 0; m < 4; ++m) { bf16_t* rowp = gates + (size_t)(row0 + ai * HALF + m * 16) * 4096 + col0;
#pragma unroll
                for (int bj = 0; bj < 2; ++bj) { const f32x4 v0 = sig4(acc[ai][bj][m][0] * 0.03125f + bv[bj][0]), v1 = sig4(acc[ai][bj][m][1] * 0.03125f + bv[bj][1]);
                    *(u32x4*)(rowp + bj * HALF) = pack8(v0, v1); } }
    }
};
struct EpiMerge {
    static constexpr bool PERM = true;
    bf16_t* merged; const bf16_t* gates;
    __device__ __forceinline__ void operator()(const f32x4 (&acc)[2][2][4][2], const Unit& u, int wr, int wc, int fr_, int fq_) const {
        int fr = fr_, fq = fq_; asm volatile("" : "+v"(fr), "+v"(fq));
        const int row0 = u.row0 + wr * 64 + fr, col0 = u.col0 + wc * 32 + 8 * fq, b = u.e;
#pragma unroll
        for (int ai = 0; ai < 2; ++ai)
#pragma unroll
            for (int m = 0; m < 4; ++m) { const size_t row = (size_t)(row0 + ai * HALF + m * 16);
#pragma unroll
                for (int bj = 0; bj < 2; ++bj) { const int col = col0 + bj * HALF;
                    const u32x4 gw = *(const u32x4*)(gates + row * 4096 + b * 1024 + col); f32x4 g0, g1; unpack8(gw, g0, g1);
                    f32x4 v0 = acc[ai][bj][m][0] * g0, v1 = acc[ai][bj][m][1] * g1;
                    if (b > 0) { const u32x4 mw = *(const u32x4*)(merged + row * DM + col); f32x4 m0, m1; unpack8(mw, m0, m1); v0 += m0; v1 += m1; }
                    *(u32x4*)(merged + row * DM + col) = pack8(v0, v1); } }
    }
};
struct EpiResid {
    static constexpr bool PERM = true;
    bf16_t* x; const bf16_t* hb;
    __device__ __forceinline__ void operator()(const f32x4 (&acc)[2][2][4][2], const Unit& u, int wr, int wc, int fr_, int fq_) const {
        int fr = fr_, fq = fq_; asm volatile("" : "+v"(fr), "+v"(fq));
        const int row0 = u.row0 + wr * 64 + fr, col0 = u.col0 + wc * 32 + 8 * fq;
#pragma unroll
        for (int ai = 0; ai < 2; ++ai)
#pragma unroll
            for (int m = 0; m < 4; ++m) { const size_t row = (size_t)(row0 + ai * HALF + m * 16);
#pragma unroll
                for (int bj = 0; bj < 2; ++bj) { const int col = col0 + bj * HALF;
                    const u32x4 hw = *(const u32x4*)(hb + row * DM + col); f32x4 h0, h1; unpack8(hw, h0, h1);
                    *(u32x4*)(x + row * DM + col) = pack8(acc[ai][bj][m][0] + h0 * ALPHA_F, acc[ai][bj][m][1] + h1 * ALPHA_F); } }
    }
};
struct EpiGateUp {
    static constexpr bool PERM = true;
    bf16_t* hid;
    __device__ __forceinline__ void operator()(const f32x4 (&acc)[2][2][4][2], const Unit& u, int wr, int wc, int fr_, int fq_) const {
        int fr = fr_, fq = fq_; asm volatile("" : "+v"(fr), "+v"(fq));
        const int hc = (u.col0 >> 1) + wc * 32 + 8 * fq;
#pragma unroll
        for (int ai = 0; ai < 2; ++ai)
#pragma unroll
            for (int m = 0; m < 4; ++m) { const int rl = ai * HALF + wr * 64 + m * 16 + fr;
                if (rl < u.nvalid) { f32x4 v0, v1;
#pragma unroll
                    for (int j = 0; j < 4; ++j) { const float g0 = acc[ai][0][m][0][j] * 0.03125f, g1 = acc[ai][0][m][1][j] * 0.03125f;
                        v0[j] = g0 * __builtin_amdgcn_rcpf(1.0f + __expf(-g0)) * (acc[ai][1][m][0][j] * 0.03125f); v1[j] = g1 * __builtin_amdgcn_rcpf(1.0f + __expf(-g1)) * (acc[ai][1][m][1][j] * 0.03125f); }
                    *(u32x4*)(hid + (size_t)(u.row0 + rl) * EH + hc) = pack8(v0, v1); } }
    }
};
struct EpiDown {
    static constexpr bool PERM = true;
    bf16_t* outs; bf16_t* x; const bf16_t* hb;
    __device__ __forceinline__ void operator()(const f32x4 (&acc)[2][2][4][2], const Unit& u, int wr, int wc, int fr_, int fq_) const {
        int fr = fr_, fq = fq_; asm volatile("" : "+v"(fr), "+v"(fq));
        const int col0 = u.col0 + wc * 32 + 8 * fq;
#pragma unroll
        for (int ai = 0; ai < 2; ++ai)
#pragma unroll
            for (int m = 0; m < 4; ++m) { const int rl = ai * HALF + wr * 64 + m * 16 + fr;
                if (rl < u.nvalid) { const size_t row = (size_t)(u.row0 + rl);
#pragma unroll
                    for (int bj = 0; bj < 2; ++bj) { const int col = col0 + bj * HALF;
                        if (u.e < 64) *(u32x4*)(outs + row * DM + col) = pack8(acc[ai][bj][m][0], acc[ai][bj][m][1]);
                        else { const size_t t = row - (size_t)8 * NTOK; const u32x4 hw = *(const u32x4*)(hb + t * DM + col); f32x4 h0, h1; unpack8(hw, h0, h1);
                            *(u32x4*)(x + t * DM + col) = pack8(acc[ai][bj][m][0] + h0 * ALPHA_F, acc[ai][bj][m][1] + h1 * ALPHA_F); } } } }
    }
};
}


namespace att {
typedef short bf16x8 __attribute__((ext_vector_type(8)));
typedef short s16x4 __attribute__((ext_vector_type(4)));
typedef float f32x16 __attribute__((ext_vector_type(16)));
typedef float f32x4 __attribute__((ext_vector_type(4)));
constexpr int KBUF = 8192, VBUF = 16384, TBUF = KBUF + VBUF;
constexpr int RPB_OFF = 4 * TBUF;
constexpr float LOG2E = 1.4426950408889634f;
#define ATT_TR(dst, addr, OFF) asm volatile("ds_read_b64_tr_b16 %0, %1 offset:%2" : "=&v"(dst) : "v"(addr), "i"(OFF) : "memory")
__device__ __forceinline__ unsigned pk2(float a, float b) { unsigned r; asm volatile("v_cvt_pk_bf16_f32 %0, %1, %2" : "=v"(r) : "v"(a), "v"(b)); return r; }

template <int MODE>
__device__ __forceinline__ void attn_unit(const Params& p, int l, int unit, LAS unsigned char* lds) {
    constexpr int NDB = MODE == 0 ? 4 : 2;
    int tid_ = TIDX; asm volatile("" : "+v"(tid_));
    const int tid = tid_, wid = __builtin_amdgcn_readfirstlane(tid >> 6), lane = tid & 63, lq = lane & 31, lh = lane >> 5;
    const bf16_t* proj = (const bf16_t*)(p.ws + OFF_PROJ); bf16_t* y = (bf16_t*)(p.ws + OFF_Y);
    const int b = unit >> 6, hd = (unit >> 4) & 3, qt = unit & 15;
    const int row0 = b * SEQ + qt * 256;
    const int qrow = row0 + wid * 32 + lq;
    const int qpos = qt * 256 + wid * 32 + lq;
    int t_lo, t_hi;
    int wr_lo = 0, wr_hi = 0;
    const int gr = qt * 4 + (wid >> 1);
    const int gc = (wid & 1) * 32 + lq;
    if (MODE == 0) { t_lo = 0; t_hi = SEQ / 64; }
    else { const int r0 = qt * 4; const int a = min(max(r0 - 4, 0), 56), c = min(max(r0 + 3 - 4, 0), 56) + 8; t_lo = a; t_hi = c;
           wr_lo = min(max(gr - 4, 0), 56); wr_hi = wr_lo + 8; }
    const int kcol = MODE == 0 ? (14 * 256 + hd * 128) : (5 * 256 + hd * 64);
    const int vcol = MODE == 0 ? (16 * 256 + hd * 128) : (6 * 256 + hd * 64);
    const int qcol = MODE == 0 ? (12 * 256 + hd * 128) : (4 * 256 + hd * 64);
    unsigned ksrc, vsrc0;
    { const int r = tid >> 3, pos = tid & 7, ch = pos ^ ((r >> 1) & 7); ksrc = (unsigned)(r * INW + kcol + ch * 8) * 2u; }
    if (MODE == 0) {
#pragma unroll
        for (int i = 0; i < 1; ++i) { const int A = 4 * i + (tid >> 7), B = (tid >> 5) & 3, Cc = (tid >> 2) & 7, Dd = tid & 3;
            const int r = 8 * A + Cc, ch = 4 * B + (Dd ^ (2 * (A & 1) + (Cc >> 2)));
            vsrc0 = (unsigned)(r * INW + vcol + ch * 8) * 2u; }
    } else { const int A = wid, B = lane >> 5, Cc = (lane >> 2) & 7, Dd = lane & 3; const int r = 8 * A + Cc, ch = 4 * B + (Dd ^ (2 * (A & 1) + (Cc >> 2)));
        vsrc0 = (unsigned)(r * INW + vcol + ch * 8) * 2u; }
    const char* kvbase = (const char*)(proj + (size_t)b * SEQ * INW);
#define ATT_DMA(tile, slot) do { const char* _g = kvbase + (size_t)(tile) * 64 * INW * 2; \
        __builtin_amdgcn_global_load_lds((const unsigned*)(_g + ksrc), (LAS unsigned*)(lds + (slot) * TBUF + wid * 1024), 16, 0, 0); \
        if (MODE == 0) { __builtin_amdgcn_global_load_lds((const unsigned*)(_g + vsrc0), (LAS unsigned*)(lds + (slot) * TBUF + KBUF + wid * 1024), 16, 0, 0); \
                         __builtin_amdgcn_global_load_lds((const unsigned*)(_g + vsrc0 + 32 * INW * 2), (LAS unsigned*)(lds + (slot) * TBUF + KBUF + 8192 + wid * 1024), 16, 0, 0); } \
        else           { __builtin_amdgcn_global_load_lds((const unsigned*)(_g + vsrc0), (LAS unsigned*)(lds + (slot) * TBUF + KBUF + wid * 2048), 16, 0, 0); } } while (0)
    const unsigned kaddr0 = (unsigned)(lq * 128 + 16 * (lh ^ ((lq >> 1) & 7)));
#define kaddr_(kk) (kaddr0 ^ (32u * (kk)))
    unsigned vaddr[2];
    { const int blk = (lane >> 4) & 1, q = (lane & 15) >> 2, pp = lane & 3;
#pragma unroll
      for (int t = 0; t < 2; ++t) vaddr[t] = (unsigned)(KBUF + 64 * (4 * lh + q) + 16 * ((2 * blk + (pp >> 1)) ^ (2 * t + lh)) + 8 * (pp & 1)); }
    const float slope2 = exp2f(-2.0f * (float)(hd + 1)) * LOG2E;
    unsigned kxw0, kxw1, qxw;
    { const unsigned short k0b = f2bf((float)lq), k1b = f2bf((float)(32 + lq));
      const unsigned short shi = f2bf(slope2), slo = f2bf(slope2 - bf2f(shi));
      kxw0 = lh ? 0u : ((unsigned)k0b | ((unsigned)k0b << 16)); kxw1 = lh ? 0u : ((unsigned)k1b | ((unsigned)k1b << 16));
      qxw = lh ? 0u : ((unsigned)shi | ((unsigned)slo << 16)); }
    float lam = 0.f, lam_init = 0.f;
    if (MODE == 0) { const float* lp = p.diff_lambda + (size_t)l * 256;
        const float s1 = wave_sum(lp[lane] * lp[64 + lane]), s2 = wave_sum(lp[128 + lane] * lp[192 + lane]);
        lam_init = 0.8f - 0.6f * __expf(-0.3f * (float)l); lam = __expf(s1) - __expf(s2) + lam_init; }
    if (MODE == 1) {
        const float* rp = p.nat_rpb + ((size_t)l * 4 + hd) * 15 * 31; LAS float* tb = (LAS float*)(lds + RPB_OFF);
        for (int i = tid; i < 15 * 64; i += NTHREADS) { const int dr = i >> 6, c = (i & 63) - 16; tb[i] = (c >= 0 && c < 31) ? rp[dr * 31 + c] * LOG2E : 0.f; }
    }
    unsigned* o1s = (unsigned*)(p.ws + OFF_DTMP) + (size_t)blockIdx.x * NTHREADS + tid;
    const size_t o1stride = (size_t)gridDim.x * NTHREADS;
    constexpr int NPASS = MODE == 0 ? 2 : 1;
#pragma unroll
    for (int pass = 0; pass < NPASS; ++pass) {
        bf16x8 qf[4];
        { const bf16_t* qp = proj + (size_t)qrow * INW + qcol + pass * 64 + 8 * lh;
#pragma unroll
          for (int kk = 0; kk < 4; ++kk) { const uint4 w = *(const uint4*)(qp + 16 * kk); const float sc = 0.125f * LOG2E;
              union { bf16x8 v; unsigned u[4]; } cv;
              cv.u[0] = pk2(lo_bf(w.x) * sc, hi_bf(w.x) * sc); cv.u[1] = pk2(lo_bf(w.y) * sc, hi_bf(w.y) * sc); cv.u[2] = pk2(lo_bf(w.z) * sc, hi_bf(w.z) * sc); cv.u[3] = pk2(lo_bf(w.w) * sc, hi_bf(w.w) * sc);
              qf[kk] = cv.v; } }
        if (MODE == 0 && pass == 1) { ksrc += 128u; }
        f32x16 o[NDB];
#pragma unroll
        for (int d = 0; d < NDB; ++d)
#pragma unroll
            for (int i = 0; i < 16; ++i) o[d][i] = 0.f;
        float m = -1e30f, lsum = 0.f;
        __syncthreads();
        ATT_DMA(t_lo, 0); if (t_lo + 1 < t_hi) ATT_DMA(t_lo + 1, 1);
        asm volatile("s_waitcnt vmcnt(0)" ::: "memory"); __syncthreads();
        const unsigned lbase = (unsigned)(uintptr_t)lds;
        const int qw0 = qt * 256 + wid * 32;
#define ATT_ACTIVE(tt) ((MODE == 0) || ((tt) >= wr_lo && (tt) < wr_hi))
#ifndef ATT_STAGGER
#define ATT_STAGGER 0
#endif
#ifndef ALIBI_MFMA
#define ALIBI_MFMA 0
#endif
#define ATT_TMODE(tt) (!ALIBI_MFMA ? 0 : ((tt) * 64 + 63 <= qw0) ? 1 : (((tt) * 64 >= qw0 + 31) ? -1 : 0))
#define ATT_QK(so, tt, S0, S1) do { \
            _Pragma("unroll") for (int i = 0; i < 16; ++i) { S0[i] = 0.f; S1[i] = 0.f; } \
            _Pragma("unroll") for (int kk = 0; kk < 4; ++kk) { \
                const bf16x8 a0 = *(const LAS bf16x8*)(lds + (so) + kaddr_(kk)), a1 = *(const LAS bf16x8*)(lds + (so) + kaddr_(kk) + 4096); \
                S0 = __builtin_amdgcn_mfma_f32_32x32x16_bf16(a0, qf[kk], S0, 0, 0, 0); S1 = __builtin_amdgcn_mfma_f32_32x32x16_bf16(a1, qf[kk], S1, 0, 0, 0); } \
            if (MODE == 0) { const int tm_ = ATT_TMODE(tt); if (tm_ != 0) { union { bf16x8 v; unsigned u[4]; } x0_, x1_, q_; \
                x0_.u[0] = kxw0; x1_.u[0] = kxw1; q_.u[0] = tm_ > 0 ? qxw : (qxw ^ 0x80008000u); x0_.u[1] = x0_.u[2] = x0_.u[3] = 0u; x1_.u[1] = x1_.u[2] = x1_.u[3] = 0u; q_.u[1] = q_.u[2] = q_.u[3] = 0u; \
                S0 = __builtin_amdgcn_mfma_f32_32x32x16_bf16(x0_.v, q_.v, S0, 0, 0, 0); S1 = __builtin_amdgcn_mfma_f32_32x32x16_bf16(x1_.v, q_.v, S1, 0, 0, 0); } } } while (0)
#define ATT_SM(tt, S0, S1) do { \
            float tmax = -3e38f, cl = 0.f; \
            if (MODE == 0) { const int tm_ = ATT_TMODE(tt); const float dq0 = (float)(qpos - (tt) * 64); \
                if (tm_ == 0) { const float dq = dq0 - (float)(4 * lh); \
                    _Pragma("unroll") for (int i = 0; i < 16; ++i) { const float c0 = (float)((i & 3) + 8 * (i >> 2)); \
                        S0[i] = S0[i] - slope2 * fabsf(dq - c0); S1[i] = S1[i] - slope2 * fabsf(dq - (c0 + 32.f)); } } \
                else cl = tm_ > 0 ? -slope2 * dq0 : slope2 * dq0; \
                _Pragma("unroll") for (int i = 0; i < 16; ++i) tmax = fmaxf(tmax, fmaxf(S0[i], S1[i])); \
                tmax += cl; \
            } else { \
                const LAS float* tb = (const LAS float*)(lds + RPB_OFF) + ((tt) - gr + 7) * 64 + 16 + 15 - gc + 4 * lh; \
                const int cs = min(max(gc - 8, 0), 48) - 4 * lh; \
                _Pragma("unroll") for (int i = 0; i < 16; ++i) { const int c0 = (i & 3) + 8 * (i >> 2); \
                    const bool v0 = (c0 >= cs) && (c0 < cs + 16), v1 = (c0 + 32 >= cs) && (c0 + 32 < cs + 16); \
                    S0[i] = v0 ? S0[i] + tb[c0] : -3e38f; S1[i] = v1 ? S1[i] + tb[c0 + 32] : -3e38f; \
                    tmax = fmaxf(tmax, fmaxf(S0[i], S1[i])); } \
            } \
            tmax = fmaxf(tmax, __shfl_xor(tmax, 32)); \
            const float mn = fmaxf(m, tmax); \
            if (__any(mn > m)) { const float al = __builtin_amdgcn_exp2f(m - mn); lsum *= al; \
                _Pragma("unroll") for (int d = 0; d < NDB; ++d) _Pragma("unroll") for (int i = 0; i < 16; ++i) o[d][i] *= al; \
                m = mn; } \
            const float mp = m - cl; float ps = 0.f; \
            _Pragma("unroll") for (int i = 0; i < 16; ++i) { S0[i] = __builtin_amdgcn_exp2f(S0[i] - mp); S1[i] = __builtin_amdgcn_exp2f(S1[i] - mp); ps += S0[i] + S1[i]; } \
            lsum += ps; \
            _Pragma("unroll") for (int ks = 0; ks < 4; ++ks) { union { bf16x8 v; unsigned u[4]; } cv; \
                _Pragma("unroll") for (int j = 0; j < 4; ++j) { const int i = 8 * (ks & 1) + 2 * j; cv.u[j] = (ks < 2) ? pk2(S0[i], S0[i + 1]) : pk2(S1[i], S1[i + 1]); } \
                pf[ks] = cv.v; } } while (0)
#define ATT_PV(so) do { \
            const unsigned vb0 = lbase + (so) + vaddr[0], vb1 = lbase + (so) + vaddr[1]; \
            _Pragma("unroll") for (int ks = 0; ks < 4; ++ks) { \
                s16x4 v0[NDB], v1[NDB]; \
                _Pragma("unroll") for (int d = 0; d < NDB; ++d) { \
                    if (ks == 0) { ATT_TR(v0[d], vb0, 0 * 4096 + d * 512); ATT_TR(v1[d], vb1, 0 * 4096 + 2048 + d * 512); } \
                    if (ks == 1) { ATT_TR(v0[d], vb0, 1 * 4096 + d * 512); ATT_TR(v1[d], vb1, 1 * 4096 + 2048 + d * 512); } \
                    if (ks == 2) { ATT_TR(v0[d], vb0, 2 * 4096 + d * 512); ATT_TR(v1[d], vb1, 2 * 4096 + 2048 + d * 512); } \
                    if (ks == 3) { ATT_TR(v0[d], vb0, 3 * 4096 + d * 512); ATT_TR(v1[d], vb1, 3 * 4096 + 2048 + d * 512); } } \
                if (NDB == 4) asm volatile("s_waitcnt lgkmcnt(0)" : "+v"(v0[0]), "+v"(v1[0]), "+v"(v0[1]), "+v"(v1[1]), "+v"(v0[2]), "+v"(v1[2]), "+v"(v0[3]), "+v"(v1[3]) :: "memory"); \
                else asm volatile("s_waitcnt lgkmcnt(0)" : "+v"(v0[0]), "+v"(v1[0]), "+v"(v0[1]), "+v"(v1[1]) :: "memory"); \
                _Pragma("unroll") for (int d = 0; d < NDB; ++d) { union { bf16x8 v; s16x4 h[2]; } cv; cv.h[0] = v0[d]; cv.h[1] = v1[d]; \
                    o[d] = __builtin_amdgcn_mfma_f32_32x32x16_bf16(cv.v, pf[ks], o[d], 0, 0, 0); } } } while (0)
        {
            f32x16 sa0, sa1; bf16x8 pf[4];
            const int grp = ATT_STAGGER ? (wid >> 2) : 0;
            for (int t = t_lo; t < t_hi; ++t) {
                const int st = (t - t_lo) & 3; const bool has = t + 2 < t_hi;
                if (has) ATT_DMA(t + 2, (st + 2) & 3);
                const bool act = ATT_ACTIVE(t);
                if (act) { ATT_QK(st * TBUF, t, sa0, sa1); ATT_SM(t, sa0, sa1); }
                if (grp == 1) { if (has) { if (MODE == 0) asm volatile("s_waitcnt vmcnt(3)" ::: "memory"); else asm volatile("s_waitcnt vmcnt(2)" ::: "memory"); } else asm volatile("s_waitcnt vmcnt(0)" ::: "memory"); __syncthreads(); }
                if (act) ATT_PV(st * TBUF);
                if (grp == 0) { if (has) { if (MODE == 0) asm volatile("s_waitcnt vmcnt(3)" ::: "memory"); else asm volatile("s_waitcnt vmcnt(2)" ::: "memory"); } else asm volatile("s_waitcnt vmcnt(0)" ::: "memory"); __syncthreads(); }
            }
        }
#undef ATT_SM
#undef ATT_PV
#undef ATT_QK
#undef ATT_TMODE
#undef ATT_ACTIVE
        const float ltot = lsum + __shfl_xor(lsum, 32), inv = 1.0f / ltot;
        if (MODE == 1) {
            bf16_t* yp = y + (size_t)qrow * 1280 + 256 + hd * 64 + 4 * lh;
#pragma unroll
            for (int d = 0; d < NDB; ++d)
#pragma unroll
                for (int g = 0; g < 4; ++g) { uint2 w; w.x = pk2(o[d][4 * g] * inv, o[d][4 * g + 1] * inv); w.y = pk2(o[d][4 * g + 2] * inv, o[d][4 * g + 3] * inv);
                    *(uint2*)(yp + 32 * d + 8 * g) = w; }
        } else if (pass == 0) {
#pragma unroll
            for (int d = 0; d < NDB; ++d)
#pragma unroll
                for (int i = 0; i < 8; ++i) o1s[(d * 8 + i) * o1stride] = pk2(o[d][2 * i] * inv, o[d][2 * i + 1] * inv);
        } else {
            float ss = 0.f;
#pragma unroll
            for (int d = 0; d < NDB; ++d)
#pragma unroll
                for (int i = 0; i < 8; ++i) { const unsigned w = o1s[(d * 8 + i) * o1stride];
                    const float a = lo_bf(w) - lam * o[d][2 * i] * inv, c = hi_bf(w) - lam * o[d][2 * i + 1] * inv; o[d][2 * i] = a; o[d][2 * i + 1] = c; ss += a * a + c * c; }
            ss += __shfl_xor(ss, 32);
            const float rs = rsqrtf(ss * (1.0f / 128.0f) + LN_EPS) * (1.0f - lam_init);
            const float* sl = p.diff_subln + (size_t)l * 512 + hd * 128 + 4 * lh;
            bf16_t* yp = y + (size_t)qrow * 1280 + 768 + hd * 128 + 4 * lh;
#pragma unroll
            for (int d = 0; d < NDB; ++d)
#pragma unroll
                for (int g = 0; g < 4; ++g) { const f32x4 sv = *(const f32x4*)(sl + 32 * d + 8 * g); uint2 w;
                    w.x = pk2(o[d][4 * g] * rs * sv[0], o[d][4 * g + 1] * rs * sv[1]); w.y = pk2(o[d][4 * g + 2] * rs * sv[2], o[d][4 * g + 3] * rs * sv[3]);
                    *(uint2*)(yp + 32 * d + 8 * g) = w; }
        }
    }
#undef ATT_DMA
#undef kaddr_
}
#undef ATT_TR
}


namespace rec {
typedef short bf16x8 __attribute__((ext_vector_type(8)));
typedef short s16x4 __attribute__((ext_vector_type(4)));
typedef float f32x16 __attribute__((ext_vector_type(16)));
typedef float f32x4 __attribute__((ext_vector_type(4)));
#define OFF_DS    OFF_EXPW
#define OFF_SP    (OFF_EXPW + 32 * MIB)
#define OFF_ADEC  (OFF_EXPW + 64 * MIB)
#define REC_TR(dst, addr, OFF) asm volatile("ds_read_b64_tr_b16 %0, %1 offset:%2" : "=&v"(dst) : "v"(addr), "i"(OFF) : "memory")
__device__ __forceinline__ unsigned offa(unsigned row, unsigned ch) { return 2048u * (row >> 3) + 512u * (ch >> 2) + 64u * (row & 7) + 16u * ((ch & 3) ^ ((row >> 2) & 3)); }
__device__ __forceinline__ unsigned offr(unsigned row, unsigned ch) { return row * 128u + 16u * (ch ^ ((row >> 1) & 7)); }
__device__ __forceinline__ unsigned pk2(float a, float b) { unsigned r; asm volatile("v_cvt_pk_bf16_f32 %0, %1, %2" : "=v"(r) : "v"(a), "v"(b)); return r; }

struct Gates { float lf[8], kk[8], qv[8], vv[8]; };
template <bool NEED_Q>
__device__ __forceinline__ void load_gates(const Params& p, int l, int m, int dir, int b, int h, int n, int c, int seg, Gates& G) {
    const bf16_t* proj = (const bf16_t*)(p.ws + OFF_PROJ);
    const int ch = h * 64 + c; const size_t tok0 = (size_t)b * SEQ + n * 64;
    float lb = 0.f, lfc = 0.f;
    if (m == 1) { if (l == 1) { const float a0 = p.hgrn_lb[(0 * 2 + dir) * 256 + ch], a1 = p.hgrn_lb[(1 * 2 + dir) * 256 + ch]; lb = 1.0f / (1.0f + __expf(a0 - a1)); } }
    else lfc = log1pf(-exp2f(-(float)(5 + dir + 2 * h)));
#pragma unroll
    for (int e = 0; e < 8; ++e) { const int ip = 8 * seg + e; const size_t tok = tok0 + (dir ? 63 - ip : ip); const bf16_t* pr = proj + tok * INW;
        if (m == 0) { G.lf[e] = lfc; G.kk[e] = bf2f(pr[256 + ch]) * 0.125f; G.vv[e] = bf2f(pr[512 + ch]); if (NEED_Q) G.qv[e] = bf2f(pr[ch]); }
        else { const float fp = bf2f(pr[(8 + dir) * 256 + ch]); const float sg = 1.0f / (1.0f + __expf(-fp));
               G.lf[e] = __logf(lb + (1.0f - lb) * sg); G.kk[e] = (1.0f - lb) * (1.0f - sg); G.vv[e] = bf2f(pr[10 * 256 + ch]);
               if (NEED_Q) { const float qq = bf2f(pr[7 * 256 + ch]); G.qv[e] = qq / (1.0f + __expf(-qq)); } } }
}

__device__ __forceinline__ void phase_a_unit(const Params& p, int l, int u, LAS unsigned char* lds) {
    int tid_ = TIDX; asm volatile("" : "+v"(tid_));
    const int tid = tid_, wid = __builtin_amdgcn_readfirstlane(tid >> 6), lane = tid & 63, c = lane, seg = wid;
    const int m = u >> 10, b = (u >> 8) & 3, h = (u >> 6) & 3, n = u & 63;
    LAS float* segsum = (LAS float*)(lds + 65536);
    Gates G[2]; float cs[2][8];
#pragma unroll
    for (int dir = 0; dir < 2; ++dir) { load_gates<false>(p, l, m, dir, b, h, n, c, seg, G[dir]);
        float a = 0.f;
#pragma unroll
        for (int e = 0; e < 8; ++e) { a += G[dir].lf[e]; cs[dir][e] = a; }
        segsum[(dir * 8 + seg) * 64 + c] = a; }
    __syncthreads();
#pragma unroll
    for (int dir = 0; dir < 2; ++dir) { float pre = 0.f, tot = 0.f;
#pragma unroll
        for (int s = 0; s < 8; ++s) { const float v = segsum[(dir * 8 + s) * 64 + c]; tot += v; pre += (s < seg) ? v : 0.f; }
        LAS unsigned char* tb = lds + dir * 16384;
#pragma unroll
        for (int e = 0; e < 8; ++e) { const int ip = 8 * seg + e; const float g = pre + cs[dir][e];
            const unsigned o = offa(ip, c >> 3) + (c & 7) * 2;
            *(LAS bf16_t*)(tb + o) = f2bf(G[dir].kk[e] * __expf(tot - g)); *(LAS bf16_t*)(tb + 1024 + o) = f2bf(G[dir].vv[e]); }
        if (seg == 0) { const int sq = ((m * 2 + dir) * 4 + b) * 4 + h; ((float*)(p.ws + OFF_ADEC))[((size_t)sq * 64 + n) * 64 + c] = __expf(tot); }
    }
    __syncthreads();
    { const int dir = wid >> 2, cb = (wid >> 1) & 1, vb = wid & 1; const unsigned lbase = (unsigned)(uintptr_t)lds + dir * 16384;
      const int lh = lane >> 5, blk = (lane >> 4) & 1, q = (lane & 15) >> 2, pp = lane & 3;
      f32x16 acc;
#pragma unroll
      for (int i = 0; i < 16; ++i) acc[i] = 0.f;
      unsigned aA[2], aB[2];
#pragma unroll
      for (int t = 0; t < 2; ++t) { const unsigned row = 8 * lh + 4 * t + q;
          aA[t] = lbase + offa(row, 4 * cb + 2 * blk + (pp >> 1)) + 8 * (pp & 1); aB[t] = lbase + 1024 + offa(row, 4 * vb + 2 * blk + (pp >> 1)) + 8 * (pp & 1); }
#pragma unroll
      for (int ks = 0; ks < 4; ++ks) { s16x4 a0, a1, b0, b1;
          if (ks == 0) { REC_TR(a0, aA[0], 0);     REC_TR(a1, aA[1], 0);     REC_TR(b0, aB[0], 0);     REC_TR(b1, aB[1], 0); }
          if (ks == 1) { REC_TR(a0, aA[0], 4096);  REC_TR(a1, aA[1], 4096);  REC_TR(b0, aB[0], 4096);  REC_TR(b1, aB[1], 4096); }
          if (ks == 2) { REC_TR(a0, aA[0], 8192);  REC_TR(a1, aA[1], 8192);  REC_TR(b0, aB[0], 8192);  REC_TR(b1, aB[1], 8192); }
          if (ks == 3) { REC_TR(a0, aA[0], 12288); REC_TR(a1, aA[1], 12288); REC_TR(b0, aB[0], 12288); REC_TR(b1, aB[1], 12288); }
          asm volatile("s_waitcnt lgkmcnt(0)" : "+v"(a0), "+v"(a1), "+v"(b0), "+v"(b1) :: "memory");
          union { bf16x8 v; s16x4 hh[2]; } ua, ub; ua.hh[0] = a0; ua.hh[1] = a1; ub.hh[0] = b0; ub.hh[1] = b1;
          acc = __builtin_amdgcn_mfma_f32_32x32x16_bf16(ua.v, ub.v, acc, 0, 0, 0); }
      const int sq = ((m * 2 + dir) * 4 + b) * 4 + h;
      bf16_t* ds = (bf16_t*)(p.ws + OFF_DS) + ((size_t)sq * 64 + n) * 4096 + 32 * vb + (lane & 31);
#pragma unroll
      for (int i = 0; i < 16; ++i) { const int cc = 32 * cb + (i & 3) + 8 * (i >> 2) + 4 * lh; ds[cc * 64] = f2bf(acc[i]); } }
    __syncthreads();
}

__device__ __forceinline__ void phase_b(const Params& p) {
    const int e2 = GTID; if (e2 >= 64 * 2048) return;
    const int sq = e2 >> 11, pr = e2 & 2047, c = pr >> 5, v2 = (pr & 31) * 2, dir = (sq >> 4) & 1;
    const unsigned* ds = (const unsigned*)(p.ws + OFF_DS) + (((size_t)sq * 64) * 4096 + c * 64 + v2) / 2;
    unsigned* sp = (unsigned*)(p.ws + OFF_SP) + (((size_t)sq * 64) * 4096 + c * 64 + v2) / 2;
    const float* ad = (const float*)(p.ws + OFF_ADEC) + (size_t)sq * 64 * 64 + c;
    float s0 = 0.f, s1 = 0.f;
    for (int n0 = 0; n0 < 64; n0 += 8) { unsigned d[8]; float a[8];
#pragma unroll
        for (int j = 0; j < 8; ++j) { const int n = dir ? 63 - (n0 + j) : n0 + j; d[j] = ds[(size_t)n * 2048]; a[j] = ad[n * 64]; }
#pragma unroll
        for (int j = 0; j < 8; ++j) { const int n = dir ? 63 - (n0 + j) : n0 + j; sp[(size_t)n * 2048] = pk2(s0, s1); s0 = a[j] * s0 + lo_bf(d[j]); s1 = a[j] * s1 + hi_bf(d[j]); } }
}

__device__ __forceinline__ void phase_c_unit(const Params& p, int l, int u, LAS unsigned char* lds) {
    int tid_ = TIDX; asm volatile("" : "+v"(tid_));
    const int tid = tid_, wid = __builtin_amdgcn_readfirstlane(tid >> 6), lane = tid & 63, c = lane, seg = wid;
    const int m = u >> 10, b = (u >> 8) & 3, h = (u >> 6) & 3, n = u & 63;
    LAS float* segsum = (LAS float*)(lds + 114688);
    LAS float* outt = (LAS float*)(lds + 81920);
    {
        const int r = tid >> 3, chn = tid & 7;
#pragma unroll
        for (int dir = 0; dir < 2; ++dir) { const int sq = ((m * 2 + dir) * 4 + b) * 4 + h;
            typedef unsigned u32x4v __attribute__((ext_vector_type(4)));
            const u32x4v w = *(const u32x4v*)((const bf16_t*)(p.ws + OFF_SP) + ((size_t)sq * 64 + n) * 4096 + r * 64 + chn * 8);
            *(LAS u32x4v*)(lds + dir * 40960 + 24576 + 1024 + offa(r, chn)) = w; } }
    Gates G[2]; float cs[2][8];
#pragma unroll
    for (int dir = 0; dir < 2; ++dir) { load_gates<true>(p, l, m, dir, b, h, n, c, seg, G[dir]);
        float a = 0.f;
#pragma unroll
        for (int e = 0; e < 8; ++e) { a += G[dir].lf[e]; cs[dir][e] = a; }
        segsum[(dir * 8 + seg) * 64 + c] = a; }
    __syncthreads();
#pragma unroll
    for (int dir = 0; dir < 2; ++dir) { float pre = 0.f, gref = 0.f;
#pragma unroll
        for (int s = 0; s < 8; ++s) { const float v = segsum[(dir * 8 + s) * 64 + c]; pre += (s < seg) ? v : 0.f; gref += (s < 4) ? v : 0.f; }
        LAS unsigned char* tb = lds + dir * 40960;
#pragma unroll
        for (int e = 0; e < 8; ++e) { const int ip = 8 * seg + e; const float g = pre + cs[dir][e];
            const unsigned orow = offr(ip, c >> 3) + (c & 7) * 2, oa = offa(ip, c >> 3) + (c & 7) * 2;
            *(LAS bf16_t*)(tb + orow) = f2bf(G[dir].kk[e] * __expf(gref - g));
            *(LAS bf16_t*)(tb + 8192 + orow) = f2bf(G[dir].qv[e] * __expf(g - gref));
            *(LAS bf16_t*)(tb + 16384 + orow) = f2bf(G[dir].qv[e] * __expf(g));
            *(LAS bf16_t*)(tb + 24576 + oa) = f2bf(G[dir].vv[e]); }
    }
    __syncthreads();
    { const int dir = wid >> 2, ib = (wid >> 1) & 1, db = wid & 1; LAS unsigned char* tb = lds + dir * 40960; const unsigned lbase = (unsigned)(uintptr_t)tb;
      const int lq = lane & 31, lh = lane >> 5, blk = (lane >> 4) & 1, q = (lane & 15) >> 2, pp = lane & 3;
      f32x16 o;
#pragma unroll
      for (int i = 0; i < 16; ++i) o[i] = 0.f;
      bf16x8 qt[4], qh[4];
#pragma unroll
      for (int kk = 0; kk < 4; ++kk) { const unsigned a = offr(32 * ib + lq, 2 * kk + lh); qt[kk] = *(const LAS bf16x8*)(tb + 8192 + a); qh[kk] = *(const LAS bf16x8*)(tb + 16384 + a); }
#pragma unroll
      for (int kb = 0; kb < 2; ++kb) { if (kb <= ib) {
          f32x16 s;
#pragma unroll
          for (int i = 0; i < 16; ++i) s[i] = 0.f;
#pragma unroll
          for (int kk = 0; kk < 4; ++kk) { const bf16x8 a = *(const LAS bf16x8*)(tb + offr(32 * kb + lq, 2 * kk + lh)); s = __builtin_amdgcn_mfma_f32_32x32x16_bf16(a, qt[kk], s, 0, 0, 0); }
          const int iq = 32 * ib + lq;
#pragma unroll
          for (int i = 0; i < 16; ++i) { const int jk = 32 * kb + (i & 3) + 8 * (i >> 2) + 4 * lh; s[i] = (jk <= iq) ? s[i] : 0.f; }
#pragma unroll
          for (int sx = 0; sx < 2; ++sx) { union { bf16x8 v; unsigned uu[4]; } pf;
#pragma unroll
              for (int j = 0; j < 4; ++j) pf.uu[j] = pk2(s[8 * sx + 2 * j], s[8 * sx + 2 * j + 1]);
              s16x4 v0, v1; const unsigned ks = 2 * kb + sx;
              const unsigned a0 = lbase + 24576 + offa(16 * ks + 0 + 4 * lh + q, 4 * db + 2 * blk + (pp >> 1)) + 8 * (pp & 1);
              const unsigned a1 = lbase + 24576 + offa(16 * ks + 8 + 4 * lh + q, 4 * db + 2 * blk + (pp >> 1)) + 8 * (pp & 1);
              REC_TR(v0, a0, 0); REC_TR(v1, a1, 0);
              asm volatile("s_waitcnt lgkmcnt(0)" : "+v"(v0), "+v"(v1) :: "memory");
              union { bf16x8 v; s16x4 hh[2]; } uv; uv.hh[0] = v0; uv.hh[1] = v1;
              o = __builtin_amdgcn_mfma_f32_32x32x16_bf16(uv.v, pf.v, o, 0, 0, 0); } } }
#pragma unroll
      for (int kk = 0; kk < 4; ++kk) { s16x4 v0, v1;
          const unsigned a0 = lbase + 24576 + 1024 + offa(16 * kk + 8 * lh + 0 + q, 4 * db + 2 * blk + (pp >> 1)) + 8 * (pp & 1);
          const unsigned a1 = lbase + 24576 + 1024 + offa(16 * kk + 8 * lh + 4 + q, 4 * db + 2 * blk + (pp >> 1)) + 8 * (pp & 1);
          REC_TR(v0, a0, 0); REC_TR(v1, a1, 0);
          asm volatile("s_waitcnt lgkmcnt(0)" : "+v"(v0), "+v"(v1) :: "memory");
          union { bf16x8 v; s16x4 hh[2]; } uv; uv.hh[0] = v0; uv.hh[1] = v1;
          o = __builtin_amdgcn_mfma_f32_32x32x16_bf16(uv.v, qh[kk], o, 0, 0, 0); }
      const int ipq = 32 * ib + lq, tokl = dir ? 63 - ipq : ipq;
#pragma unroll
      for (int g = 0; g < 4; ++g) { f32x4 w; w[0] = o[4 * g]; w[1] = o[4 * g + 1]; w[2] = o[4 * g + 2]; w[3] = o[4 * g + 3];
          *(LAS f32x4*)(outt + (dir * 64 + tokl) * 64 + 32 * db + 8 * g + 4 * lh) = w; } }
    __syncthreads();
    { const int i = tid >> 3, vs = (tid & 7) * 8; const size_t tok = (size_t)b * SEQ + n * 64 + i;
      float o[8]; float ss = 0.f;
#pragma unroll
      for (int j = 0; j < 8; ++j) { o[j] = outt[i * 64 + vs + j] + outt[(64 + i) * 64 + vs + j]; ss += o[j] * o[j]; }
      ss += __shfl_xor(ss, 1); ss += __shfl_xor(ss, 2); ss += __shfl_xor(ss, 4);
      const float rs = rsqrtf(ss * (1.0f / 64.0f) + LN_EPS);
      const float* gn = (m == 0 ? p.ret_gn : p.hgrn_gn) + (size_t)l * 256 + h * 64 + vs;
      const bf16_t* gp = (const bf16_t*)(p.ws + OFF_PROJ) + tok * INW + (m == 0 ? 3 : 11) * 256 + h * 64 + vs;
      const uint4 gw = *(const uint4*)gp; const unsigned gwa[4] = {gw.x, gw.y, gw.z, gw.w}; unsigned ow[4];
#pragma unroll
      for (int j = 0; j < 4; ++j) { const float g0 = lo_bf(gwa[j]), g1 = hi_bf(gwa[j]);
          ow[j] = pk2(o[2 * j] * rs * gn[2 * j] * (g0 / (1.0f + __expf(-g0))), o[2 * j + 1] * rs * gn[2 * j + 1] * (g1 / (1.0f + __expf(-g1)))); }
      *(uint4*)((bf16_t*)(p.ws + OFF_Y) + tok * 1280 + (m == 0 ? 0 : 512) + h * 64 + vs) = make_uint4(ow[0], ow[1], ow[2], ow[3]); }
    __syncthreads();
}
#undef REC_TR
}

__device__ __forceinline__ unsigned pk4_fp8(float a, float b, float c, float d) { int w = __builtin_amdgcn_cvt_pk_fp8_f32(a, b, 0, false); w = __builtin_amdgcn_cvt_pk_fp8_f32(c, d, w, true); return (unsigned)w; }
__device__ __forceinline__ void tconv8_tile(const float* src, int lds_, int sk0, int sc0, unsigned char* dst, int ldd, int dn0, int dk0, float scale, unsigned char* tile) {
    const int t = TIDX;
#pragma unroll
    for (int i = 0; i < 2; ++i) {
        const int row = (t >> 4) + 32 * i, c4 = (t & 15) * 4;
        const float4 v = *(const float4*)(src + (size_t)(sk0 + row) * lds_ + sc0 + c4);
        const unsigned w = pk4_fp8(v.x * scale, v.y * scale, v.z * scale, v.w * scale);
        tile[(c4 + 0) * 80 + row] = (unsigned char)(w & 255u); tile[(c4 + 1) * 80 + row] = (unsigned char)((w >> 8) & 255u);
        tile[(c4 + 2) * 80 + row] = (unsigned char)((w >> 16) & 255u); tile[(c4 + 3) * 80 + row] = (unsigned char)(w >> 24);
    }
    __syncthreads();
    if (t < 256) { const int n = t >> 2, ch = t & 3;
      const uint4 w = *(const uint4*)&tile[n * 80 + ch * 16];
      *(uint4*)(dst + (size_t)(dn0 + n) * ldd + dk0 + ch * 16) = w; }
    __syncthreads();
}

__device__ __forceinline__ void ph_conv_mixer_weights(const Params& p, int l, bf16_t* tile) {
    bf16_t* wtig = (bf16_t*)(p.ws + OFF_WTIG); bf16_t* wtbr = (bf16_t*)(p.ws + OFF_WTBR); bf16_t* wtout = (bf16_t*)(p.ws + OFF_WTOUT);
    const int n_in = 1152, n_gate = 1024, n_br = 64, n_bd = 128, n_out = 256;
    const int total = n_in + n_gate + 3 * n_br + n_bd + n_out;
    for (int j = blockIdx.x; j < total; j += gridDim.x) {
        int q = j;
        if (q < n_in) { const int kt = q & 15, nt = q >> 4; tconv_tile(p.w_in + (size_t)l * DM * INW, INW, kt * 64, nt * 64, wtig, DM, nt * 64, kt * 64, tile); continue; }
        q -= n_in;
        if (q < n_gate) { const int kt = q & 15, nt = q >> 4; tconv8_tile(p.w_gate + (size_t)l * DM * 4096, 4096, kt * 64, nt * 64, (unsigned char*)(p.ws + OFF_W8), DM, nt * 64, kt * 64, 32.0f, (unsigned char*)tile); continue; }
        q -= n_gate;
        if (q < 3 * n_br) { const int which = q / n_br, r = q % n_br, kt = r & 3, nt = r >> 2;
            const float* src = (which == 0 ? p.w_br_ret : which == 1 ? p.w_br_nat : p.w_br_hgrn) + (size_t)l * 256 * DM;
            tconv_tile(src, DM, kt * 64, nt * 64, wtbr, 1280, nt * 64, which * 256 + kt * 64, tile); continue; }
        q -= 3 * n_br;
        if (q < n_bd) { const int kt = q & 7, nt = q >> 3; tconv_tile(p.w_br_diff + (size_t)l * 512 * DM, DM, kt * 64, nt * 64, wtbr, 1280, nt * 64, 768 + kt * 64, tile); continue; }
        q -= n_bd;
        { const int kt = q & 15, nt = q >> 4; tconv_tile(p.w_out + (size_t)l * DM * DM, DM, kt * 64, nt * 64, wtout, DM, nt * 64, kt * 64, tile); }
    }
}
__device__ __forceinline__ void ph_conv_expert_weights(const Params& p, int l, bf16_t* tile) {
    bf16_t* gu = (bf16_t*)(p.ws + OFF_EXPGU); bf16_t* dn = (bf16_t*)(p.ws + OFF_EXPDN);
    const int per_gu = 128, per_dn = 64, total = 65 * (per_gu + per_dn);
    for (int j = blockIdx.x; j < total; j += gridDim.x) {
        const int e = j / (per_gu + per_dn); int q = j % (per_gu + per_dn);
        if (q < per_gu) {
            const int kt = q & 15, nt = (q >> 4) & 1, blk = q >> 5;
            const float* src = (e < 64) ? (((blk & 1) ? p.w_e_up : p.w_e_gate) + ((size_t)l * NEXP + e) * DM * EH) : (((blk & 1) ? p.w_s_up : p.w_s_gate) + (size_t)l * DM * EH);
            tconv8_tile(src, EH, kt * 64, (blk >> 1) * 128 + nt * 64, (unsigned char*)gu + (size_t)e * 512 * DM, DM, blk * 128 + nt * 64, kt * 64, 32.0f, (unsigned char*)tile);
        } else { q -= per_gu;
            const int kt = q & 3, nt = q >> 2;
            const float* src = (e < 64) ? (p.w_e_down + ((size_t)l * NEXP + e) * EH * DM) : (p.w_s_down + (size_t)l * EH * DM);
            tconv_tile(src, DM, kt * 64, nt * 64, dn + (size_t)e * DM * EH, EH, nt * 64, kt * 64, tile);
        }
    }
}

__device__ __forceinline__ void ph_ln_in(const Params& p) {
    bf16_t* hb = (bf16_t*)(p.ws + OFF_HB);
    const int lane = TIDX & 63, gw = GTID >> 6, nw = GSIZE >> 6;
    for (int row = gw; row < NTOK; row += nw) {
        const float* xr = p.x + (size_t)row * DM;
        float4 v[4]; float s = 0.f;
#pragma unroll
        for (int i = 0; i < 4; ++i) { v[i] = *(const float4*)(xr + i * 256 + lane * 4); s += v[i].x + v[i].y + v[i].z + v[i].w; }
        const float mu = wave_sum(s) * (1.0f / DM); float q = 0.f;
#pragma unroll
        for (int i = 0; i < 4; ++i) { v[i].x -= mu; v[i].y -= mu; v[i].z -= mu; v[i].w -= mu; q += v[i].x * v[i].x + v[i].y * v[i].y + v[i].z * v[i].z + v[i].w * v[i].w; }
        const float rs = rsqrtf(wave_sum(q) * (1.0f / DM) + LN_EPS);
#pragma unroll
        for (int i = 0; i < 4; ++i) { const int c = i * 256 + lane * 4;
            const float4 g = *(const float4*)(p.ln_in_g + c), b = *(const float4*)(p.ln_in_b + c);
            const float o0 = v[i].x * rs * g.x + b.x, o1 = v[i].y * rs * g.y + b.y, o2 = v[i].z * rs * g.z + b.z, o3 = v[i].w * rs * g.w + b.w;
            ushort4 o; o.x = f2bf(o0); o.y = f2bf(o1); o.z = f2bf(o2); o.w = f2bf(o3);
            *(ushort4*)(hb + (size_t)row * DM + c) = o;
            *(unsigned*)(p.ws + OFF_HB8 + (size_t)row * DM + c) = pk4_fp8(o0, o1, o2, o3); }
    }
}

__device__ __forceinline__ void ph_inproj_naive(const Params& p, int l) {
    const bf16_t* hb = (const bf16_t*)(p.ws + OFF_HB); const bf16_t* wt = (const bf16_t*)(p.ws + OFF_WTIG);
    bf16_t* proj = (bf16_t*)(p.ws + OFF_PROJ); bf16_t* gates = (bf16_t*)(p.ws + OFF_GATES);
    const float* bg = p.b_gate + (size_t)l * 4096;
    const long total = (long)NTOK * 8704;
    for (long it = GTID; it < total; it += GSIZE) {
        const int col = (int)(it % 8704), row = (int)(it / 8704);
        const float acc = dot_bf16(hb + (size_t)row * DM, wt + (size_t)col * DM, DM);
        if (col < INW) proj[(size_t)row * INW + col] = f2bf(acc);
        else gates[(size_t)row * 4096 + (col - INW)] = f2bf(sigmoidf_(acc + bg[col - INW]));
    }
}

__device__ __forceinline__ void ph_recur_naive(const Params& p, int l) {
    if (blockIdx.x >= 64 || TIDX >= 64) return;
    const int seq = blockIdx.x, lane = TIDX;
    const int m = seq >> 5, dir = (seq >> 4) & 1, b = (seq >> 2) & 3, h = seq & 3;
    const bf16_t* proj = (const bf16_t*)(p.ws + OFF_PROJ);
    float* otmp = (float*)(p.ws + OFF_OTMP) + (size_t)(m * 2 + dir) * NTOK * 256;
    float S[64];
#pragma unroll
    for (int k = 0; k < 64; ++k) S[k] = 0.f;
    const int ch = h * 64 + lane;
    float lb = 0.f;
    if (m == 1 && l == 1) { const float a0 = p.hgrn_lb[(0 * 2 + dir) * 256 + ch], a1 = p.hgrn_lb[(1 * 2 + dir) * 256 + ch]; lb = 1.0f / (1.0f + __expf(a0 - a1)); }
    const float fret = 1.0f - exp2f(-(dir ? 6.0f : 5.0f) - 2.0f * (float)h);
    for (int s = 0; s < SEQ; ++s) {
        const int tt = dir ? (SEQ - 1 - s) : s; const size_t row = (size_t)b * SEQ + tt;
        const bf16_t* pr = proj + row * INW;
        float qv, kv, vv, fv;
        if (m == 0) { qv = bf2f(pr[ch]); kv = bf2f(pr[256 + ch]) * 0.125f; vv = bf2f(pr[512 + ch]); fv = fret; }
        else { qv = siluf_(bf2f(pr[7 * 256 + ch])); const float fp = bf2f(pr[(8 + dir) * 256 + ch]);
               fv = lb + (1.0f - lb) * sigmoidf_(fp); kv = (1.0f - lb) * sigmoidf_(-fp); vv = bf2f(pr[10 * 256 + ch]); }
        float o = 0.f;
#pragma unroll
        for (int k = 0; k < 64; ++k) {
            const float fk = __int_as_float(__builtin_amdgcn_readlane(__float_as_int(fv), k));
            const float kk = __int_as_float(__builtin_amdgcn_readlane(__float_as_int(kv), k));
            const float qk = __int_as_float(__builtin_amdgcn_readlane(__float_as_int(qv), k));
            S[k] = fk * S[k] + kk * vv; o += S[k] * qk;
        }
        otmp[row * 256 + ch] = o;
    }
}
__device__ __forceinline__ void ph_recur_finish(const Params& p, int l) {
    const bf16_t* proj = (const bf16_t*)(p.ws + OFF_PROJ); bf16_t* y = (bf16_t*)(p.ws + OFF_Y);
    const float* otmp = (const float*)(p.ws + OFF_OTMP);
    const int lane = TIDX & 63, gw = GTID >> 6, nw = GSIZE >> 6;
    for (int it = gw; it < NTOK * 8; it += nw) {
        const int h = it & 3, m = (it >> 2) & 1, row = it >> 3, ch = h * 64 + lane;
        const float o = otmp[((size_t)(m * 2 + 0) * NTOK + row) * 256 + ch] + otmp[((size_t)(m * 2 + 1) * NTOK + row) * 256 + ch];
        const float ms = wave_sum(o * o) * (1.0f / 64.0f);
        const float gn = (m == 0 ? p.ret_gn : p.hgrn_gn)[(size_t)l * 256 + ch];
        const float g = bf2f(proj[(size_t)row * INW + (m == 0 ? 3 : 11) * 256 + ch]);
        y[(size_t)row * 1280 + (m == 0 ? 0 : 512) + ch] = f2bf(o * rsqrtf(ms + LN_EPS) * gn * siluf_(g));
    }
}

__device__ __forceinline__ void ph_nat_naive(const Params& p, int l) {
    const bf16_t* proj = (const bf16_t*)(p.ws + OFF_PROJ); bf16_t* y = (bf16_t*)(p.ws + OFF_Y);
    const float* rpb = p.nat_rpb + (size_t)l * 4 * 15 * 31;
    for (int it = GTID; it < NTOK * 4; it += GSIZE) {
        const int row = it % NTOK, h = it / NTOK;
        const int b = row >> 12, r = (row >> 6) & 63, c = row & 63;
        const int rs = min(max(r - 4, 0), 56), cs = min(max(c - 8, 0), 48);
        float q[64], acc[64];
        { const bf16_t* qp = proj + (size_t)row * INW + 4 * 256 + h * 64;
#pragma unroll
          for (int d = 0; d < 64; ++d) { q[d] = bf2f(qp[d]); acc[d] = 0.f; } }
        float mx = -1e30f, lsum = 0.f;
        for (int kr = 0; kr < 8; ++kr) for (int kc = 0; kc < 16; ++kc) {
            const int rr = rs + kr, cc = cs + kc; const size_t krow = (size_t)b * SEQ + rr * 64 + cc;
            const bf16_t* kp = proj + krow * INW + 5 * 256 + h * 64; const bf16_t* vp = proj + krow * INW + 6 * 256 + h * 64;
            float s = 0.f;
#pragma unroll
            for (int d = 0; d < 64; ++d) s += q[d] * bf2f(kp[d]);
            int dc = cc - c; dc = min(max(dc, -15), 15) + 15;
            s = s * 0.125f + rpb[(h * 15 + (rr - r + 7)) * 31 + dc];
            const float mn = fmaxf(mx, s), sc = __expf(mx - mn), pe = __expf(s - mn);
            lsum = lsum * sc + pe; mx = mn;
#pragma unroll
            for (int d = 0; d < 64; ++d) acc[d] = acc[d] * sc + pe * bf2f(vp[d]);
        }
        const float inv = 1.0f / lsum;
        bf16_t* yp = y + (size_t)row * 1280 + 256 + h * 64;
#pragma unroll
        for (int d = 0; d < 64; ++d) yp[d] = f2bf(acc[d] * inv);
    }
}

__device__ __forceinline__ void ph_diff_naive(const Params& p, int l) {
    const bf16_t* proj = (const bf16_t*)(p.ws + OFF_PROJ); bf16_t* dt = (bf16_t*)(p.ws + OFF_DTMP);
    for (int it = GTID; it < NTOK * 32; it += GSIZE) {
        const int row = it % NTOK, grp = it / NTOK;
        const int dvq = grp & 3, j = (grp >> 2) & 1, h = grp >> 3;
        const int b = row >> 12, qpos = row & 4095;
        const float slope = exp2f(-2.0f * (float)(h + 1));
        float q[64], acc[32];
        { const bf16_t* qp = proj + (size_t)row * INW + 12 * 256 + h * 128 + j * 64;
#pragma unroll
          for (int d = 0; d < 64; ++d) q[d] = bf2f(qp[d]) * 0.125f;
#pragma unroll
          for (int d = 0; d < 32; ++d) acc[d] = 0.f; }
        float mx = -1e30f, lsum = 0.f;
        for (int kpos = 0; kpos < SEQ; ++kpos) {
            const size_t krow = (size_t)b * SEQ + kpos;
            const bf16_t* kp = proj + krow * INW + 14 * 256 + h * 128 + j * 64; const bf16_t* vp = proj + krow * INW + 16 * 256 + h * 128 + dvq * 32;
            float s = 0.f;
#pragma unroll
            for (int d = 0; d < 64; d += 8) { const uint4 kv = *(const uint4*)(kp + d);
                s += q[d] * lo_bf(kv.x) + q[d + 1] * hi_bf(kv.x) + q[d + 2] * lo_bf(kv.y) + q[d + 3] * hi_bf(kv.y) + q[d + 4] * lo_bf(kv.z) + q[d + 5] * hi_bf(kv.z) + q[d + 6] * lo_bf(kv.w) + q[d + 7] * hi_bf(kv.w); }
            s -= slope * fabsf((float)(qpos - kpos));
            if (s > mx) { const float sc = __expf(mx - s); lsum *= sc;
#pragma unroll
                for (int d = 0; d < 32; ++d) acc[d] *= sc;
                mx = s; }
            const float pe = __expf(s - mx); lsum += pe;
#pragma unroll
            for (int d = 0; d < 32; d += 8) { const uint4 vv = *(const uint4*)(vp + d);
                acc[d] += pe * lo_bf(vv.x); acc[d + 1] += pe * hi_bf(vv.x); acc[d + 2] += pe * lo_bf(vv.y); acc[d + 3] += pe * hi_bf(vv.y);
                acc[d + 4] += pe * lo_bf(vv.z); acc[d + 5] += pe * hi_bf(vv.z); acc[d + 6] += pe * lo_bf(vv.w); acc[d + 7] += pe * hi_bf(vv.w); }
        }
        const float inv = 1.0f / lsum;
        bf16_t* op = dt + (((size_t)row * 4 + h) * 2 + j) * 128 + dvq * 32;
#pragma unroll
        for (int d = 0; d < 32; ++d) op[d] = f2bf(acc[d] * inv);
    }
}
__device__ __forceinline__ void ph_diff_finish(const Params& p, int l) {
    const bf16_t* dt = (const bf16_t*)(p.ws + OFF_DTMP); bf16_t* y = (bf16_t*)(p.ws + OFF_Y);
    const int lane = TIDX & 63, gw = GTID >> 6, nw = GSIZE >> 6;
    const float* lp = p.diff_lambda + (size_t)l * 256;
    const float s1 = wave_sum(lp[lane] * lp[64 + lane]), s2 = wave_sum(lp[128 + lane] * lp[192 + lane]);
    const float lam_init = 0.8f - 0.6f * __expf(-0.3f * (float)l);
    const float lam = __expf(s1) - __expf(s2) + lam_init;
    for (int it = gw; it < NTOK * 4; it += nw) {
        const int h = it & 3, row = it >> 2;
        const bf16_t* o1 = dt + (((size_t)row * 4 + h) * 2 + 0) * 128; const bf16_t* o2 = o1 + 128;
        const float a = bf2f(o1[lane]) - lam * bf2f(o2[lane]), c = bf2f(o1[64 + lane]) - lam * bf2f(o2[64 + lane]);
        const float ms = wave_sum(a * a + c * c) * (1.0f / 128.0f), rs = rsqrtf(ms + LN_EPS) * (1.0f - lam_init);
        const float* sl = p.diff_subln + (size_t)l * 512 + h * 128;
        bf16_t* yp = y + (size_t)row * 1280 + 768 + h * 128;
        yp[lane] = f2bf(a * rs * sl[lane]); yp[64 + lane] = f2bf(c * rs * sl[64 + lane]);
    }
}

__device__ __forceinline__ void ph_merge_naive(const Params& p) {
    const bf16_t* y = (const bf16_t*)(p.ws + OFF_Y); const bf16_t* gates = (const bf16_t*)(p.ws + OFF_GATES); const bf16_t* wt = (const bf16_t*)(p.ws + OFF_WTBR);
    bf16_t* mg = (bf16_t*)(p.ws + OFF_MERGED);
    for (int it = GTID; it < NTOK * DM; it += GSIZE) {
        const int col = it & 1023, row = it >> 10;
        const bf16_t* yr = y + (size_t)row * 1280; const bf16_t* wr = wt + (size_t)col * 1280; const bf16_t* gr = gates + (size_t)row * 4096 + col;
        const float v = bf2f(gr[0]) * dot_bf16(yr, wr, 256) + bf2f(gr[1024]) * dot_bf16(yr + 256, wr + 256, 256)
                      + bf2f(gr[2048]) * dot_bf16(yr + 512, wr + 512, 256) + bf2f(gr[3072]) * dot_bf16(yr + 768, wr + 768, 512);
        mg[(size_t)row * DM + col] = f2bf(v);
    }
}
__device__ __forceinline__ void ph_outproj_naive(const Params& p) {
    const bf16_t* mg = (const bf16_t*)(p.ws + OFF_MERGED); const bf16_t* wt = (const bf16_t*)(p.ws + OFF_WTOUT); const bf16_t* hb = (const bf16_t*)(p.ws + OFF_HB);
    bf16_t* x = (bf16_t*)(p.ws + OFF_X);
    for (int it = GTID; it < NTOK * DM; it += GSIZE) {
        const int col = it & 1023, row = it >> 10;
        x[it] = f2bf(ALPHA_F * bf2f(hb[it]) + dot_bf16(mg + (size_t)row * DM, wt + (size_t)col * DM, DM));
    }
}

__device__ __forceinline__ void ph_ln1_route(const Params& p, int l, float* hrow_all) {
    const bf16_t* x = (const bf16_t*)(p.ws + OFF_X); bf16_t* hb = (bf16_t*)(p.ws + OFF_HB);
    int* tope = (int*)(p.ws + OFF_TOPE); float* topw = (float*)(p.ws + OFF_TOPW); int* topp = (int*)(p.ws + OFF_TOPP);
    unsigned* cnt = (unsigned*)(p.ws + OFF_CNT) + l * 64; int* perm = (int*)(p.ws + OFF_PERM);
    const float* g1 = p.ln1_g + (size_t)l * DM; const float* b1 = p.ln1_b + (size_t)l * DM;
    const float* wr = p.w_router + (size_t)l * DM * NEXP; const float rb = p.router_bias[l * NEXP + (TIDX & 63)];
    const int lane = TIDX & 63, wv = TIDX >> 6, gw = GTID >> 6, nw = GSIZE >> 6;
    float* hrow = hrow_all + wv * DM;
    for (int row = gw; row < NTOK; row += nw) {
        const bf16_t* xr = x + (size_t)row * DM;
        float v[16]; float s = 0.f;
#pragma unroll
        for (int i = 0; i < 4; ++i) { const ushort4 u = *(const ushort4*)(xr + i * 256 + lane * 4); v[i * 4] = bf2f(u.x); v[i * 4 + 1] = bf2f(u.y); v[i * 4 + 2] = bf2f(u.z); v[i * 4 + 3] = bf2f(u.w);
            s += v[i * 4] + v[i * 4 + 1] + v[i * 4 + 2] + v[i * 4 + 3]; }
        const float mu = wave_sum(s) * (1.0f / DM); float q = 0.f;
#pragma unroll
        for (int i = 0; i < 16; ++i) { v[i] -= mu; q += v[i] * v[i]; }
        const float rs = rsqrtf(wave_sum(q) * (1.0f / DM) + LN_EPS);
#pragma unroll
        for (int i = 0; i < 4; ++i) { const int c = i * 256 + lane * 4;
            const float4 g = *(const float4*)(g1 + c), b = *(const float4*)(b1 + c);
            float4 o; o.x = v[i * 4] * rs * g.x + b.x; o.y = v[i * 4 + 1] * rs * g.y + b.y; o.z = v[i * 4 + 2] * rs * g.z + b.z; o.w = v[i * 4 + 3] * rs * g.w + b.w;
            *(float4*)(hrow + c) = o;
            ushort4 ob; ob.x = f2bf(o.x); ob.y = f2bf(o.y); ob.z = f2bf(o.z); ob.w = f2bf(o.w);
            *(ushort4*)(hb + (size_t)row * DM + c) = ob; }
        __builtin_amdgcn_wave_barrier();
        float lg = 0.f;
        for (int k = 0; k < DM; k += 4) { const float4 hv = *(const float4*)(hrow + k);
            lg += hv.x * wr[(size_t)k * NEXP + lane]; lg += hv.y * wr[(size_t)(k + 1) * NEXP + lane]; lg += hv.z * wr[(size_t)(k + 2) * NEXP + lane]; lg += hv.w * wr[(size_t)(k + 3) * NEXP + lane]; }
        __builtin_amdgcn_wave_barrier();
        const float score = sigmoidf_(lg), biased = score + rb;
        int rk = 0;
#pragma unroll
        for (int j = 0; j < 8; ++j) { const int src = (lane & ~7) | j; const float o = __shfl(biased, src); rk += (o > biased || (o == biased && src < lane)) ? 1 : 0; }
        float gs = (rk < 2) ? biased : 0.f;
        gs += __shfl_xor(gs, 1); gs += __shfl_xor(gs, 2); gs += __shfl_xor(gs, 4);
        int grk = 0;
#pragma unroll
        for (int j = 0; j < 8; ++j) { const float o = __shfl(gs, j * 8); const int myg = lane >> 3; grk += (o > gs || (o == gs && j < myg)) ? 1 : 0; }
        const float mval = (grk < 4) ? biased : -1e30f;
        int erk = 0;
        for (int j = 0; j < 64; ++j) { const float o = __shfl(mval, j); erk += (o > mval || (o == mval && j < lane)) ? 1 : 0; }
        const bool sel = erk < 8;
        const float wsum = wave_sum(sel ? score : 0.f);
        if (sel) {
            const float w = score / (wsum + 1e-20f) * 2.5f;
            const unsigned pos = atomicAdd(&cnt[lane], 1u);
            tope[(size_t)row * 8 + erk] = lane; topw[(size_t)row * 8 + erk] = w; topp[(size_t)row * 8 + erk] = (int)pos; perm[(size_t)lane * NTOK + pos] = row;
        }
    }
}

__device__ __forceinline__ void ph_hid_naive(const Params& p, int l, int* offs) {
    const bf16_t* hb = (const bf16_t*)(p.ws + OFF_HB); const bf16_t* gu = (const bf16_t*)(p.ws + OFF_EXPGU); bf16_t* hid = (bf16_t*)(p.ws + OFF_HID);
    const int* tope = (const int*)(p.ws + OFF_TOPE); const float* topw = (const float*)(p.ws + OFF_TOPW); const int* topp = (const int*)(p.ws + OFF_TOPP);
    const long total = (long)NTOK * 9 * EH;
    for (long it = GTID; it < total; it += GSIZE) {
        const int j = (int)(it & 255); const int slot = (int)(it >> 8); const int t = slot / 9, k = slot % 9;
        int e; float w; size_t orow;
        if (k < 8) { e = tope[t * 8 + k]; w = topw[t * 8 + k]; orow = (size_t)offs[e] + topp[t * 8 + k]; } else { e = 64; w = 1.0f; orow = (size_t)8 * NTOK + t; }
        const bf16_t* wg = gu + ((size_t)e * 512 + (j >> 7) * 256 + (j & 127)) * DM; const bf16_t* wu = wg + (size_t)128 * DM;
        const float g = dot_bf16(hb + (size_t)t * DM, wg, DM), u = dot_bf16(hb + (size_t)t * DM, wu, DM);
        (void)w; hid[orow * EH + j] = f2bf(siluf_(g) * u);
    }
}
__device__ __forceinline__ void ph_down_naive(const Params& p, int l, int* offs) {
    const bf16_t* hb = (const bf16_t*)(p.ws + OFF_HB); const bf16_t* dn = (const bf16_t*)(p.ws + OFF_EXPDN); const bf16_t* hid = (const bf16_t*)(p.ws + OFF_HID);
    bf16_t* outs = (bf16_t*)(p.ws + OFF_OUTS); bf16_t* x = (bf16_t*)(p.ws + OFF_X);
    const long total = (long)NTOK * 9 * DM;
    for (long it = GTID; it < total; it += GSIZE) {
        const int n = (int)(it & 1023); const int row = (int)(it >> 10);
        if (row < 8 * NTOK) { int e = 0;
            for (int q = 1; q < 64; ++q) e += (row >= offs[q]) ? 1 : 0;
            outs[(size_t)row * DM + n] = f2bf(dot_bf16(hid + (size_t)row * EH, dn + ((size_t)e * DM + n) * EH, EH));
        } else { const int t = row - 8 * NTOK;
            x[(size_t)t * DM + n] = f2bf(ALPHA_F * bf2f(hb[(size_t)t * DM + n]) + dot_bf16(hid + (size_t)row * EH, dn + ((size_t)64 * DM + n) * EH, EH)); }
    }
}
__device__ __forceinline__ void ph_combine_ln2(const Params& p, int l, int* offs) {
    const bf16_t* x = (const bf16_t*)(p.ws + OFF_X); const bf16_t* outs = (const bf16_t*)(p.ws + OFF_OUTS); bf16_t* hb = (bf16_t*)(p.ws + OFF_HB);
    const int* tope = (const int*)(p.ws + OFF_TOPE); const int* topp = (const int*)(p.ws + OFF_TOPP); const float* topw = (const float*)(p.ws + OFF_TOPW);
    const float* g2 = p.ln2_g + (size_t)l * DM; const float* b2 = p.ln2_b + (size_t)l * DM;
    const int lane = TIDX & 63, gw = GTID >> 6, nw = GSIZE >> 6;
    for (int row = gw; row < NTOK; row += nw) {
        float v[16];
#pragma unroll
        for (int i = 0; i < 4; ++i) { const ushort4 u = *(const ushort4*)(x + (size_t)row * DM + i * 256 + lane * 4); v[i * 4] = bf2f(u.x); v[i * 4 + 1] = bf2f(u.y); v[i * 4 + 2] = bf2f(u.z); v[i * 4 + 3] = bf2f(u.w); }
        for (int k = 0; k < 8; ++k) { const size_t r = (size_t)offs[tope[row * 8 + k]] + topp[row * 8 + k]; const float w = topw[row * 8 + k];
#pragma unroll
            for (int i = 0; i < 4; ++i) { const ushort4 u = *(const ushort4*)(outs + r * DM + i * 256 + lane * 4); v[i * 4] += w * bf2f(u.x); v[i * 4 + 1] += w * bf2f(u.y); v[i * 4 + 2] += w * bf2f(u.z); v[i * 4 + 3] += w * bf2f(u.w); } }
        float s = 0.f;
#pragma unroll
        for (int i = 0; i < 16; ++i) s += v[i];
        const float mu = wave_sum(s) * (1.0f / DM); float q = 0.f;
#pragma unroll
        for (int i = 0; i < 16; ++i) { v[i] -= mu; q += v[i] * v[i]; }
        const float rs = rsqrtf(wave_sum(q) * (1.0f / DM) + LN_EPS);
#pragma unroll
        for (int i = 0; i < 4; ++i) { const int c = i * 256 + lane * 4;
            const float4 g = *(const float4*)(g2 + c), b = *(const float4*)(b2 + c);
            float4 o; o.x = v[i * 4] * rs * g.x + b.x; o.y = v[i * 4 + 1] * rs * g.y + b.y; o.z = v[i * 4 + 2] * rs * g.z + b.z; o.w = v[i * 4 + 3] * rs * g.w + b.w;
            if (l == NLAYER - 1) *(float4*)(p.out + (size_t)row * DM + c) = o;
            else { ushort4 ob; ob.x = f2bf(o.x); ob.y = f2bf(o.y); ob.z = f2bf(o.z); ob.w = f2bf(o.w); *(ushort4*)(hb + (size_t)row * DM + c) = ob;
                   *(unsigned*)(p.ws + OFF_HB8 + (size_t)row * DM + c) = pk4_fp8(o.x, o.y, o.z, o.w); } }
    }
}

__device__ __forceinline__ void ph_ln1_route_fast(const Params& p, int l, LAS unsigned char* lds) {
    typedef float f32x4 __attribute__((ext_vector_type(4)));
    int tid_ = TIDX; asm volatile("" : "+v"(tid_));
    const int tid = tid_, wv = __builtin_amdgcn_readfirstlane(tid >> 6), lane = tid & 63;
    const bf16_t* x = (const bf16_t*)(p.ws + OFF_X); bf16_t* hb = (bf16_t*)(p.ws + OFF_HB);
    int* tope = (int*)(p.ws + OFF_TOPE); float* topw = (float*)(p.ws + OFF_TOPW); int* topp = (int*)(p.ws + OFF_TOPP);
    unsigned* cnt = (unsigned*)(p.ws + OFF_CNT) + l * 64; int* perm = (int*)(p.ws + OFF_PERM);
    const float* g1 = p.ln1_g + (size_t)l * DM; const float* b1 = p.ln1_b + (size_t)l * DM;
    const float* wr = p.w_router + (size_t)l * DM * NEXP; const float rb = p.router_bias[l * NEXP + lane];
    constexpr int HS = 1028;
    LAS float* hrow = (LAS float*)lds;
    LAS float* lgt = (LAS float*)(lds + 32 * HS * 4);
    for (int r0 = blockIdx.x * 32; r0 < NTOK; r0 += gridDim.x * 32) {
#pragma unroll
        for (int rr = 0; rr < 4; ++rr) { const int rl = 4 * wv + rr, row = r0 + rl;
            const bf16_t* xr = x + (size_t)row * DM;
            float v[16]; float s = 0.f;
#pragma unroll
            for (int i = 0; i < 4; ++i) { const ushort4 u = *(const ushort4*)(xr + i * 256 + lane * 4); v[i * 4] = bf2f(u.x); v[i * 4 + 1] = bf2f(u.y); v[i * 4 + 2] = bf2f(u.z); v[i * 4 + 3] = bf2f(u.w);
                s += v[i * 4] + v[i * 4 + 1] + v[i * 4 + 2] + v[i * 4 + 3]; }
            const float mu = wave_sum(s) * (1.0f / DM); float q = 0.f;
#pragma unroll
            for (int i = 0; i < 16; ++i) { v[i] -= mu; q += v[i] * v[i]; }
            const float rs = rsqrtf(wave_sum(q) * (1.0f / DM) + LN_EPS);
#pragma unroll
            for (int i = 0; i < 4; ++i) { const int c = i * 256 + lane * 4;
                const float4 g = *(const float4*)(g1 + c), b = *(const float4*)(b1 + c);
                f32x4 o; o[0] = v[i * 4] * rs * g.x + b.x; o[1] = v[i * 4 + 1] * rs * g.y + b.y; o[2] = v[i * 4 + 2] * rs * g.z + b.z; o[3] = v[i * 4 + 3] * rs * g.w + b.w;
                *(LAS f32x4*)(hrow + rl * HS + c) = o;
                ushort4 ob; ob.x = f2bf(o[0]); ob.y = f2bf(o[1]); ob.z = f2bf(o[2]); ob.w = f2bf(o[3]);
                *(ushort4*)(hb + (size_t)row * DM + c) = ob;
                *(unsigned*)(p.ws + OFF_HB8 + (size_t)row * DM + c) = pk4_fp8(o[0], o[1], o[2], o[3]); } }
        __syncthreads();
        { const int rt = wv & 1, et = wv >> 1; const int li = lane & 15, kq = lane >> 4;
          f32x4 acc = {0.f, 0.f, 0.f, 0.f};
          const LAS float* ap = hrow + (rt * 16 + li) * HS + 4 * kq;
          const float* bp = wr + (size_t)(4 * kq) * NEXP + et * 16 + li;
#pragma unroll 4
          for (int s = 0; s < 64; ++s) { const f32x4 a = *(const LAS f32x4*)(ap + 16 * s);
              const float b0 = bp[(size_t)(16 * s + 0) * NEXP], b1v = bp[(size_t)(16 * s + 1) * NEXP], b2 = bp[(size_t)(16 * s + 2) * NEXP], b3 = bp[(size_t)(16 * s + 3) * NEXP];
              acc = __builtin_amdgcn_mfma_f32_16x16x4f32(a[0], b0, acc, 0, 0, 0); acc = __builtin_amdgcn_mfma_f32_16x16x4f32(a[1], b1v, acc, 0, 0, 0);
              acc = __builtin_amdgcn_mfma_f32_16x16x4f32(a[2], b2, acc, 0, 0, 0); acc = __builtin_amdgcn_mfma_f32_16x16x4f32(a[3], b3, acc, 0, 0, 0); }
#pragma unroll
          for (int r = 0; r < 4; ++r) lgt[(rt * 16 + 4 * kq + r) * 65 + et * 16 + li] = acc[r]; }
        __syncthreads();
#pragma unroll
        for (int rr = 0; rr < 4; ++rr) { const int rl = 4 * wv + rr, row = r0 + rl;
            const float lg = lgt[rl * 65 + lane];
            const float score = sigmoidf_(lg), biased = score + rb;
            int rk = 0;
#pragma unroll
            for (int j = 0; j < 8; ++j) { const int src = (lane & ~7) | j; const float o = __shfl(biased, src); rk += (o > biased || (o == biased && src < lane)) ? 1 : 0; }
            float gs = (rk < 2) ? biased : 0.f;
            gs += __shfl_xor(gs, 1); gs += __shfl_xor(gs, 2); gs += __shfl_xor(gs, 4);
            int grk = 0;
#pragma unroll
            for (int j = 0; j < 8; ++j) { const float o = __shfl(gs, j * 8); const int myg = lane >> 3; grk += (o > gs || (o == gs && j < myg)) ? 1 : 0; }
            const float mval = (grk < 4) ? biased : -1e30f;
            int erk = 0;
#pragma unroll 8
            for (int j = 0; j < 64; ++j) { const float o = __shfl(mval, j); erk += (o > mval || (o == mval && j < lane)) ? 1 : 0; }
            const bool sel = erk < 8;
            const float wsum = wave_sum(sel ? score : 0.f);
            if (sel) { const float w = score / (wsum + 1e-20f) * 2.5f;
                const unsigned pos = atomicAdd(&cnt[lane], 1u);
                tope[(size_t)row * 8 + erk] = lane; topw[(size_t)row * 8 + erk] = w; topp[(size_t)row * 8 + erk] = (int)pos; perm[(size_t)lane * NTOK + pos] = row; } }
        __syncthreads();
    }
}

__device__ __forceinline__ void ph_inproj_fast(const Params& p, int l, LAS unsigned char* stage) {
    { g8::StaticSched S; S.init(p.ws + OFF_HB, DM, p.ws + OFF_WTIG, DM, NTOK, INW, DM, (int)gridDim.x, (int)blockIdx.x);
      g8::EpiProj E{(bf16_t*)(p.ws + OFF_PROJ)};
      g8::gemm_stream(stage, S, E); }
    {
      g8::StaticSched S; S.init(p.ws + OFF_HB8, DM / 2, p.ws + OFF_W8, DM / 2, NTOK, 4096, DM / 2, (int)gridDim.x, (int)blockIdx.x);
      g8::EpiGate8 E{(bf16_t*)(p.ws + OFF_GATES), p.b_gate + (size_t)l * 4096};
      g8::gemm_stream<g8::EpiGate8, g8::StaticSched, true>(stage, S, E); }
}
__device__ __forceinline__ void ph_merge_fast(const Params& p, LAS unsigned char* stage) {
    g8::MergeSched S; S.A = (const char*)(p.ws + OFF_Y); S.B = (const char*)(p.ws + OFF_WTBR); S.lda = 1280; S.ldb = 1280; S.K = 256; S.G = (int)gridDim.x; S.c = (int)blockIdx.x;
    g8::EpiMerge E{(bf16_t*)(p.ws + OFF_MERGED), (const bf16_t*)(p.ws + OFF_GATES)};
    g8::gemm_stream(stage, S, E);
}
__device__ __forceinline__ void ph_outproj_fast(const Params& p, LAS unsigned char* stage) {
    g8::StaticSched S; S.init(p.ws + OFF_MERGED, DM, p.ws + OFF_WTOUT, DM, NTOK, DM, DM, (int)gridDim.x, (int)blockIdx.x);
    g8::EpiResid E{(bf16_t*)(p.ws + OFF_X), (const bf16_t*)(p.ws + OFF_HB)};
    g8::gemm_stream(stage, S, E);
}
__device__ __forceinline__ void ph_hid_fast(const Params& p, const LAS int* offs, const LAS int* tp, LAS unsigned char* stage) {
    g8::GroupSched<true> S; S.A = (const char*)(p.ws + OFF_HB8); S.B = (const char*)(p.ws + OFF_EXPGU); S.bstride = (size_t)512 * DM; S.lda = DM / 2; S.ldb = DM / 2; S.K = DM / 2;
    S.offs = offs; S.tp = tp; S.perm = (const int*)(p.ws + OFF_PERM); S.NC = 2; S.G = (int)gridDim.x; S.c = (int)blockIdx.x;
    g8::EpiGateUp E{(bf16_t*)(p.ws + OFF_HID)};
    g8::gemm_stream<g8::EpiGateUp, g8::GroupSched<true>, true>(stage, S, E);
}
__device__ __forceinline__ void ph_down_fast(const Params& p, const LAS int* offs, const LAS int* tp, LAS unsigned char* stage) {
    g8::GroupSched<false> S; S.A = (const char*)(p.ws + OFF_HID); S.B = (const char*)(p.ws + OFF_EXPDN); S.bstride = (size_t)DM * EH * 2; S.lda = EH; S.ldb = EH; S.K = EH;
    S.offs = offs; S.tp = tp; S.perm = nullptr; S.NC = 4; S.G = (int)gridDim.x; S.c = (int)blockIdx.x;
    g8::EpiDown E{(bf16_t*)(p.ws + OFF_OUTS), (bf16_t*)(p.ws + OFF_X), (const bf16_t*)(p.ws + OFF_HB)};
    g8::gemm_stream(stage, S, E);
}

__device__ __forceinline__ void ph_attn_fast(const Params& p, int l, LAS unsigned char* stage) {
    if (FAST_MASK & 32) { for (int v = blockIdx.x; v < 256; v += gridDim.x) { const int u = (gridDim.x == 256) ? (((v & 7) * 2 + ((v >> 3) >> 4)) * 16 + ((v >> 3) & 15)) : v; att::attn_unit<1>(p, l, u, stage); } } else ph_nat_naive(p, l);
    if (FAST_MASK & 64) { for (int v = blockIdx.x; v < 256; v += gridDim.x) { const int u = (gridDim.x == 256) ? (((v & 7) * 2 + ((v >> 3) >> 4)) * 16 + ((v >> 3) & 15)) : v; att::attn_unit<0>(p, l, u, stage); } } else ph_diff_naive(p, l);
}

#define NPH 16
#define STAGE_OFF 2048
__global__ void __launch_bounds__(NTHREADS, 2) fwd_kernel(Params p) {
    extern __shared__ __attribute__((aligned(16))) unsigned char lds[];
    LAS unsigned char* ldsl = (LAS unsigned char*)lds;
    volatile LAS unsigned* xbw = (volatile LAS unsigned*)ldsl;
    LAS int* offs = (LAS int*)(ldsl + 16);
    LAS int* tp = (LAS int*)(ldsl + 512);
    LAS unsigned char* stage = ldsl + STAGE_OFF;
    unsigned char* scratch = lds + STAGE_OFF;
    if (threadIdx.x < 4) xbw[threadIdx.x] = 0u;
    if ((threadIdx.x & 63) == 0) ((volatile LAS int*)(ldsl + WIDTAB_OFF))[(unsigned)__builtin_amdgcn_s_getreg((5 << 11) | 4) & 63u] = (int)(threadIdx.x >> 6);
    __syncthreads();
    XcdBarrier bar = xcd_barrier_post((unsigned*)(p.ws + OFF_BAR), xbw);
    const int lo = p.ph_lo, hi = p.ph_hi;
#define IN(k) (lo <= (k) && (k) < hi)
#define SEAM(k) do { if (IN(k) && IN((k) + 1)) xcd_barrier(bar); } while (0)
#define RUNPH(k, body) if (IN(pb + (k))) { body; if (REPEAT_PH == (k)) { xcd_barrier(bar); body; } }
#define LAYER_BODY(l) do { \
        const int pb = l * NPH; \
        RUNPH(0, { ph_conv_mixer_weights(p, l, (bf16_t*)scratch); if (l == 0) ph_ln_in(p); }) \
        SEAM(pb + 0); \
        RUNPH(1, { if (FAST_MASK & 1) ph_inproj_fast(p, l, stage); else ph_inproj_naive(p, l); }) \
        SEAM(pb + 1); \
        if (REPEAT_PH == 99) { for (int q_ = 0; q_ < 8; ++q_) xcd_barrier(bar); } \
        RUNPH(2, { if (FAST_MASK & 128) { for (int u = blockIdx.x; u < 2048; u += gridDim.x) rec::phase_a_unit(p, l, u, stage); } else ph_recur_naive(p, l); }) \
        SEAM(pb + 2); \
        RUNPH(10, { if (FAST_MASK & 128) rec::phase_b(p); ph_attn_fast(p, l, stage); }) \
        if (IN(pb + 10) && IN(pb + 3)) xcd_barrier(bar); \
        RUNPH(3, { if (FAST_MASK & 128) { for (int u = blockIdx.x; u < 2048; u += gridDim.x) rec::phase_c_unit(p, l, u, stage); } else ph_recur_finish(p, l); if (!(FAST_MASK & 64)) ph_diff_finish(p, l); }) \
        SEAM(pb + 3); \
        RUNPH(4, { if (FAST_MASK & 2) ph_merge_fast(p, stage); else ph_merge_naive(p); }) \
        SEAM(pb + 4); \
        RUNPH(5, { if (FAST_MASK & 4) ph_outproj_fast(p, stage); else ph_outproj_naive(p); __syncthreads(); ph_conv_expert_weights(p, l, (bf16_t*)scratch); }) \
        SEAM(pb + 5); \
        if (IN(pb + 6)) { if (FAST_MASK & 256) ph_ln1_route_fast(p, l, stage); else ph_ln1_route(p, l, (float*)scratch); } \
        SEAM(pb + 6); \
        if (IN(pb + 7) || IN(pb + 8) || IN(pb + 9)) { \
            __syncthreads(); \
            if (TIDX == 0) { const unsigned* cnt = (const unsigned*)(p.ws + OFF_CNT) + l * 64; int a = 0, t = 0; \
                for (int e = 0; e < 64; ++e) { offs[e] = a; tp[e] = t; const int c = (int)cnt[e]; a += c; t += (c + 255) >> 8; } \
                offs[64] = a; tp[64] = t; offs[65] = a + NTOK; tp[65] = t + NTOK / 256; } \
            __syncthreads(); \
        } \
        RUNPH(7, { if (FAST_MASK & 8) ph_hid_fast(p, offs, tp, stage); else ph_hid_naive(p, l, (int*)(lds + 16)); }) \
        SEAM(pb + 7); \
        RUNPH(8, { if (FAST_MASK & 16) ph_down_fast(p, offs, tp, stage); else ph_down_naive(p, l, (int*)(lds + 16)); }) \
        SEAM(pb + 8); \
        RUNPH(9, { ph_combine_ln2(p, l, (int*)(lds + 16)); }) \
        SEAM(pb + 9); \
    } while (0)
    LAYER_BODY(0);
    LAYER_BODY(1);
#undef IN
#undef SEAM
}

#define LDS_BYTES (STAGE_OFF + 144 * 1024)

extern "C" void kernel_launch(void* const* d_in, const int* in_sizes, int n_in, void* d_out, int out_size, void* d_ws, size_t ws_size, hipStream_t stream) {
    static int grid = 0;
    if (grid == 0) {
        if (n_in != 29 || out_size != NTOK * DM || ws_size < WS_END) { fprintf(stderr, "kernel_launch: unexpected shapes (n_in %d out %d ws %zu need %zu)\n", n_in, out_size, ws_size, (size_t)WS_END); grid = -1; return; }
        int dev = 0, cus = 0, per_cu = 0;
        if (hipGetDevice(&dev) != hipSuccess || hipDeviceGetAttribute(&cus, hipDeviceAttributeMultiprocessorCount, dev) != hipSuccess) { grid = -1; return; }
        if (hipFuncSetAttribute((const void*)fwd_kernel, hipFuncAttributeMaxDynamicSharedMemorySize, LDS_BYTES) != hipSuccess) { grid = -1; return; }
        if (hipOccupancyMaxActiveBlocksPerMultiprocessor(&per_cu, (const void*)fwd_kernel, NTHREADS, LDS_BYTES) != hipSuccess || per_cu < 1) { fprintf(stderr, "occupancy query: %d\n", per_cu); }
        (void)hipGetLastError();
        grid = cus;
    }
    if (grid < 0) return;
    hipMemsetAsync((char*)d_ws, 0, CTL_ZERO_BYTES, stream);
    Params p{};
    const float** pp = (const float**)&p;
    for (int i = 0; i < 29; ++i) pp[i] = (const float*)d_in[i];
    p.out = (float*)d_out; p.ws = (unsigned char*)d_ws; p.ph_lo = 0; p.ph_hi = NLAYER * NPH;
    hipLaunchKernelGGL(fwd_kernel, dim3(grid), dim3(NTHREADS), LDS_BYTES, stream, p);
}

#ifdef TEST_PHASE
__global__ void __launch_bounds__(NTHREADS, 2) test_kernel(Params p) {
    extern __shared__ __attribute__((aligned(16))) unsigned char lds[];
    LAS unsigned char* ldsl = (LAS unsigned char*)lds;
    LAS int* offs = (LAS int*)(ldsl + 16); LAS int* tp = (LAS int*)(ldsl + 512);
    LAS unsigned char* stage = ldsl + STAGE_OFF;
#if TEST_PHASE == 1
    ph_inproj_fast(p, 1, stage);
#elif TEST_PHASE == 2
    ph_merge_fast(p, stage);
#elif TEST_PHASE == 3
    ph_outproj_fast(p, stage);
#elif TEST_PHASE == 4
    ph_hid_fast(p, offs, tp, stage);
#elif TEST_PHASE == 5
    ph_down_fast(p, offs, tp, stage);
#elif TEST_PHASE == 12
    { g8::StaticSched S; S.init(p.ws + OFF_HB8, DM / 2, p.ws + OFF_W8, DM / 2, NTOK, 4096, DM / 2, (int)gridDim.x, (int)blockIdx.x);
      g8::EpiGate8 E{(bf16_t*)(p.ws + OFF_GATES), p.b_gate};
      g8::gemm_stream<g8::EpiGate8, g8::StaticSched, true>(stage, S, E); }
#elif TEST_PHASE == 13
    { g8::StaticSched S; S.init(p.ws + OFF_HB8, DM / 2, p.ws + OFF_W8, DM / 2, NTOK, 4096, DM / 2, (int)gridDim.x, (int)blockIdx.x);
      g8::EpiGate8 E{(bf16_t*)(p.ws + OFF_GATES), p.b_gate};
      g8::gemm_stream<g8::EpiGate8, g8::StaticSched, false>(stage, S, E); }
#elif TEST_PHASE == 6
    att::attn_unit<0>(p, 1, blockIdx.x, stage);
#elif TEST_PHASE == 7
    att::attn_unit<1>(p, 1, blockIdx.x, stage);
#elif TEST_PHASE == 8
    rec::phase_c_unit(p, 1, blockIdx.x, stage);
#elif TEST_PHASE == 9
    rec::phase_a_unit(p, 1, blockIdx.x, stage);
#elif TEST_PHASE == 10
    ph_ln1_route_fast(p, 1, stage);
#endif
}
#endif
```
